# Optimizing an MI355X kernel written in HIP

```python
import math
import jax, jax.numpy as jnp
from jax import lax
import numpy as np

D_MODEL = 1024
BATCH = 8
SEQ = 2048
DEPTH = 4

N_MIXERS = 4
N_A = (DEPTH + 3) // 4
N_B = (DEPTH + 2) // 4
N_C = (DEPTH + 1) // 4
N_D = DEPTH // 4
EPS = 1e-6
NEG_INF = -1e30

SSM_WIDTH = D_MODEL
SSM_GROUP = 16
SSM_GROUPS = SSM_WIDTH // SSM_GROUP
SSM_STATE = 64
DT_MIN = 1e-3
DT_MAX = 1e-1

HEAD_DIM = 64
SWA_HEADS = D_MODEL // HEAD_DIM
SWA_KV_HEADS = SWA_HEADS // 8
SWA_WIDTH = SWA_HEADS * HEAD_DIM
WINDOW = 128

REL_BUCKETS = 32
REL_MAX_DIST = 128

MLA_HEADS = 16
MLA_NOPE = 64
MLA_ROPE = 32
MLA_V = 64
MLA_KV_RANK = 256
MLA_Q_RANK = 768
MLA_WIDTH = MLA_HEADS * MLA_V
ROPE_BASE = 10000.0
Q_BLOCK = 128

SGU_WIDTH = D_MODEL
SGU_CHUNK = 128
SGU_GROUPS = 16
SGU_GROUP_DIM = SGU_WIDTH // SGU_GROUPS

kernel_name = 'hybrid_interleaved_s5_swa_mla_sgu'


def rmsnorm(x, g):
    xf = x.astype(jnp.float32)
    y = xf * lax.rsqrt(jnp.mean(xf * xf, axis=-1, keepdims=True) + EPS)
    return (y * g.astype(jnp.float32)).astype(x.dtype)


def layernorm(x, g, b):
    xf = x.astype(jnp.float32)
    mu = jnp.mean(xf, axis=-1, keepdims=True)
    var = jnp.mean(jnp.square(xf - mu), axis=-1, keepdims=True)
    y = (xf - mu) * lax.rsqrt(var + EPS) * g.astype(jnp.float32) + b.astype(jnp.float32)
    return y.astype(x.dtype)


def _ssm_combine(left, right):
    a1r, a1i, b1r, b1i = left
    a2r, a2i, b2r, b2i = right
    return (a2r * a1r - a2i * a1i,
            a2r * a1i + a2i * a1r,
            a2r * b1r - a2i * b1i + b2r,
            a2r * b1i + a2i * b1r + b2i)


def s5_mixer(u, lam_re, lam_im, log_dt, b_re, b_im, c_re, c_im, d_skip, w_glu, b_glu):
    f32 = jnp.float32
    bsz, L, _ = u.shape
    ug = u.astype(f32).reshape(bsz, L, SSM_GROUPS, SSM_GROUP)
    lr = lam_re.astype(f32)
    li = lam_im.astype(f32)
    dt = jnp.exp(log_dt.astype(f32))[:, None]
    mag = jnp.exp(lr * dt)
    ab_re = mag * jnp.cos(li * dt)
    ab_im = mag * jnp.sin(li * dt)
    den = lr * lr + li * li
    nr = ab_re - 1.0
    f_re = (nr * lr + ab_im * li) / den
    f_im = (ab_im * lr - nr * li) / den
    br = b_re.astype(f32)
    bi = b_im.astype(f32)
    bb_re = f_re[..., None] * br - f_im[..., None] * bi
    bb_im = f_re[..., None] * bi + f_im[..., None] * br
    bu_re = jnp.einsum('blgh,gph->blgp', ug, bb_re)
    bu_im = jnp.einsum('blgh,gph->blgp', ug, bb_im)
    a_re = jnp.broadcast_to(ab_re, (1, L) + ab_re.shape)
    a_im = jnp.broadcast_to(ab_im, (1, L) + ab_im.shape)
    _, _, s_re, s_im = lax.associative_scan(_ssm_combine, (a_re, a_im, bu_re, bu_im), axis=1)
    y = (jnp.einsum('blgp,ghp->blgh', s_re, c_re.astype(f32))
         - jnp.einsum('blgp,ghp->blgh', s_im, c_im.astype(f32)))
    y = y.reshape(bsz, L, SSM_WIDTH) + d_skip.astype(f32) * u.astype(f32)
    y = jax.nn.gelu(y).astype(u.dtype)
    return y * jax.nn.sigmoid(y @ w_glu + b_glu)


def s5_branch(h, w_in, lam_re, lam_im, log_dt, b_re, b_im, c_re, c_im, d_skip, w_glu, b_glu, w_out):
    u, z = jnp.split(h @ w_in, [SSM_WIDTH], axis=-1)
    y = s5_mixer(u, lam_re, lam_im, log_dt, b_re, b_im, c_re, c_im, d_skip, w_glu, b_glu)
    return (y * jax.nn.silu(z)) @ w_out


def t5_bucket(dist):
    max_exact = REL_BUCKETS // 2
    dist_f = jnp.maximum(dist, 1).astype(jnp.float32)
    large = max_exact + (jnp.log(dist_f / max_exact) / math.log(REL_MAX_DIST / max_exact)
                         * (REL_BUCKETS - max_exact)).astype(jnp.int32)
    large = jnp.minimum(large, REL_BUCKETS - 1)
    return jnp.where(dist < max_exact, dist, large)


def sliding_window_attention(q, k, v, sinks, rel_bias):
    bsz, L = q.shape[0], q.shape[1]
    nb = L // WINDOW
    grp = SWA_HEADS // SWA_KV_HEADS
    qb = q.reshape(bsz, nb, WINDOW, SWA_KV_HEADS, grp, HEAD_DIM)

    def band(t):
        prev = jnp.pad(t, ((0, 0), (WINDOW, 0), (0, 0), (0, 0)))[:, :L]
        shp = (bsz, nb, WINDOW, SWA_KV_HEADS, HEAD_DIM)
        return jnp.concatenate([prev.reshape(shp), t.reshape(shp)], axis=2)

    kb = band(k)
    vb = band(v)
    s = jnp.einsum('bnqhgd,bnkhd->bnhgqk', qb, kb).astype(jnp.float32) * (HEAD_DIM ** -0.5)
    qi = jnp.arange(WINDOW)[:, None]
    kj = jnp.arange(2 * WINDOW)[None, :]
    dist = qi + WINDOW - kj
    blk = jnp.arange(nb)[:, None, None]
    valid = (dist >= 0) & (dist < WINDOW) & (blk * WINDOW + kj - WINDOW >= 0)
    bias = rel_bias[t5_bucket(jnp.maximum(dist, 0))]
    bias = jnp.transpose(bias, (2, 0, 1)).reshape(SWA_KV_HEADS, grp, WINDOW, 2 * WINDOW).astype(jnp.float32)
    s = jnp.where(valid[None, :, None, None], s + bias, NEG_INF)
    sink = jnp.broadcast_to(sinks.astype(jnp.float32).reshape(SWA_KV_HEADS, grp, 1, 1), s.shape[:-1] + (1,))
    p = jax.nn.softmax(jnp.concatenate([s, sink], axis=-1), axis=-1)[..., :-1]
    o = jnp.einsum('bnhgqk,bnkhd->bnqhgd', p.astype(v.dtype), vb)
    return o.reshape(bsz, L, SWA_WIDTH)


def swa_branch(h, w_in, sinks, w_out, rel_bias):
    bsz, L, _ = h.shape
    kv_w = SWA_KV_HEADS * HEAD_DIM
    q, k, v, z = jnp.split(h @ w_in, [SWA_WIDTH, SWA_WIDTH + kv_w, SWA_WIDTH + 2 * kv_w], axis=-1)
    q = q.reshape(bsz, L, SWA_HEADS, HEAD_DIM)
    k = k.reshape(bsz, L, SWA_KV_HEADS, HEAD_DIM)
    v = v.reshape(bsz, L, SWA_KV_HEADS, HEAD_DIM)
    o = sliding_window_attention(q, k, v, sinks, rel_bias)
    return (o * jax.nn.silu(z)) @ w_out


def rope_tables(L):
    inv = ROPE_BASE ** (-jnp.arange(0, MLA_ROPE, 2, dtype=jnp.float32) / MLA_ROPE)
    ang = jnp.arange(L, dtype=jnp.float32)[:, None] * inv[None, :]
    return jnp.cos(ang), jnp.sin(ang)


def apply_rope(x, cos, sin):
    xf = x.astype(jnp.float32)
    x1, x2 = jnp.split(xf, 2, axis=-1)
    return jnp.concatenate([x1 * cos - x2 * sin, x2 * cos + x1 * sin], axis=-1).astype(x.dtype)


def causal_block_attention(q, k, v):
    bsz, L, H, dk = q.shape
    nb = L // Q_BLOCK
    scale = dk ** -0.5
    qb = q.reshape(bsz, nb, Q_BLOCK, H, dk).transpose(1, 0, 2, 3, 4)
    kpos = jnp.arange(L)

    def one_block(args):
        qi, n = args
        s = jnp.einsum('bqhd,bkhd->bhqk', qi, k).astype(jnp.float32) * scale
        qpos = n * Q_BLOCK + jnp.arange(Q_BLOCK)
        s = jnp.where(kpos[None, :] <= qpos[:, None], s, NEG_INF)
        p = jax.nn.softmax(s, axis=-1).astype(v.dtype)
        return jnp.einsum('bhqk,bkhd->bqhd', p, v)

    o = lax.map(one_block, (qb, jnp.arange(nb)))
    return o.transpose(1, 0, 2, 3, 4).reshape(bsz, L, H, v.shape[-1])


def mla_branch(h, w_in, q_norm, kv_norm, w_uq, w_ukv, w_out):
    bsz, L, _ = h.shape
    c_q, c_kv, k_rope, z = jnp.split(
        h @ w_in, [MLA_Q_RANK, MLA_Q_RANK + MLA_KV_RANK, MLA_Q_RANK + MLA_KV_RANK + MLA_ROPE], axis=-1)
    q = (rmsnorm(c_q, q_norm) @ w_uq).reshape(bsz, L, MLA_HEADS, MLA_NOPE + MLA_ROPE)
    kv = (rmsnorm(c_kv, kv_norm) @ w_ukv).reshape(bsz, L, MLA_HEADS, MLA_NOPE + MLA_V)
    cos, sin = rope_tables(L)
    q = jnp.concatenate([q[..., :MLA_NOPE], apply_rope(q[..., MLA_NOPE:], cos[:, None], sin[:, None])], axis=-1)
    k_rope = apply_rope(k_rope, cos, sin)
    k = jnp.concatenate([kv[..., :MLA_NOPE],
                         jnp.broadcast_to(k_rope[:, :, None, :], (bsz, L, MLA_HEADS, MLA_ROPE))], axis=-1)
    o = causal_block_attention(q, k, kv[..., MLA_NOPE:])
    return (o.reshape(bsz, L, MLA_WIDTH) * jax.nn.silu(z)) @ w_out


def sgu_branch(h, w_in, ln_g, ln_b, w_s, b_s, w_out):
    bsz, L, _ = h.shape
    uv, z = jnp.split(h @ w_in, [2 * SGU_WIDTH], axis=-1)
    u, v = jnp.split(jax.nn.gelu(uv), 2, axis=-1)
    v = layernorm(v, ln_g, ln_b).reshape(bsz, L // SGU_CHUNK, SGU_CHUNK, SGU_GROUPS, SGU_GROUP_DIM)
    tril = jnp.tril(jnp.ones((SGU_CHUNK, SGU_CHUNK), dtype=bool))
    w = jnp.where(tril[None], w_s, 0.0)
    s = jnp.einsum('gts,bnsgc->bntgc', w, v) + b_s.T[:, :, None]
    s = s.reshape(bsz, L, SGU_WIDTH)
    return (u * s * jax.nn.silu(z)) @ w_out


def setup_inputs(seed: int = 0) -> dict:
    key = jax.random.key(seed)
    ks = iter(jax.random.split(key, 40))
    f32 = jnp.float32

    def nrm(shape, scale):
        return jax.random.normal(next(ks), shape, f32) * scale

    x = nrm((BATCH, SEQ, D_MODEL), 1.0)
    pre_norm = 1.0 + nrm((DEPTH, D_MODEL), 0.05)
    post_norm = 1.0 + nrm((DEPTH, D_MODEL), 0.05)
    rel_bias = nrm((REL_BUCKETS, SWA_HEADS), 0.5)
    a_w_in = nrm((N_A, D_MODEL, 2 * SSM_WIDTH), D_MODEL ** -0.5)
    n_idx = jnp.arange(SSM_STATE, dtype=f32)
    a_lam_re = -0.5 + nrm((N_A, SSM_GROUPS, SSM_STATE), 0.01)
    a_lam_im = jnp.pi * n_idx + nrm((N_A, SSM_GROUPS, SSM_STATE), 0.01)
    a_log_dt = jax.random.uniform(next(ks), (N_A, SSM_GROUPS), f32, math.log(DT_MIN), math.log(DT_MAX))
    a_b_re = nrm((N_A, SSM_GROUPS, SSM_STATE, SSM_GROUP), (2 * SSM_GROUP) ** -0.5)
    a_b_im = nrm((N_A, SSM_GROUPS, SSM_STATE, SSM_GROUP), (2 * SSM_GROUP) ** -0.5)
    a_c_re = nrm((N_A, SSM_GROUPS, SSM_GROUP, SSM_STATE), SSM_STATE ** -0.5)
    a_c_im = nrm((N_A, SSM_GROUPS, SSM_GROUP, SSM_STATE), SSM_STATE ** -0.5)
    a_d = nrm((N_A, SSM_WIDTH), 1.0)
    a_w_glu = nrm((N_A, SSM_WIDTH, SSM_WIDTH), SSM_WIDTH ** -0.5)
    a_b_glu = nrm((N_A, SSM_WIDTH), 0.02)
    a_w_out = nrm((N_A, SSM_WIDTH, D_MODEL), SSM_WIDTH ** -0.5)
    b_w_in = nrm((N_B, D_MODEL, 2 * SWA_WIDTH + 2 * SWA_KV_HEADS * HEAD_DIM), D_MODEL ** -0.5)
    b_sinks = nrm((N_B, SWA_HEADS), 1.0)
    b_w_out = nrm((N_B, SWA_WIDTH, D_MODEL), SWA_WIDTH ** -0.5)
    c_w_in = nrm((N_C, D_MODEL, MLA_Q_RANK + MLA_KV_RANK + MLA_ROPE + MLA_WIDTH), D_MODEL ** -0.5)
    c_q_norm = 1.0 + nrm((N_C, MLA_Q_RANK), 0.05)
    c_kv_norm = 1.0 + nrm((N_C, MLA_KV_RANK), 0.05)
    c_w_uq = nrm((N_C, MLA_Q_RANK, MLA_HEADS * (MLA_NOPE + MLA_ROPE)), MLA_Q_RANK ** -0.5)
    c_w_ukv = nrm((N_C, MLA_KV_RANK, MLA_HEADS * (MLA_NOPE + MLA_V)), MLA_KV_RANK ** -0.5)
    c_w_out = nrm((N_C, MLA_WIDTH, D_MODEL), MLA_WIDTH ** -0.5)
    d_w_in = nrm((N_D, D_MODEL, 3 * SGU_WIDTH), D_MODEL ** -0.5)
    d_ln_g = 1.0 + nrm((N_D, SGU_WIDTH), 0.05)
    d_ln_b = nrm((N_D, SGU_WIDTH), 0.02)
    d_w_s = nrm((N_D, SGU_GROUPS, SGU_CHUNK, SGU_CHUNK), 0.5 * SGU_CHUNK ** -0.5)
    d_b_s = 1.0 + nrm((N_D, SGU_GROUPS, SGU_CHUNK), 0.1)
    d_w_out = nrm((N_D, SGU_WIDTH, D_MODEL), SGU_WIDTH ** -0.5)
    return {'x': x, 'pre_norm': pre_norm, 'post_norm': post_norm, 'rel_bias': rel_bias,
            'a_w_in': a_w_in, 'a_lam_re': a_lam_re, 'a_lam_im': a_lam_im, 'a_log_dt': a_log_dt,
            'a_b_re': a_b_re, 'a_b_im': a_b_im, 'a_c_re': a_c_re, 'a_c_im': a_c_im, 'a_d': a_d,
            'a_w_glu': a_w_glu, 'a_b_glu': a_b_glu, 'a_w_out': a_w_out,
            'b_w_in': b_w_in, 'b_sinks': b_sinks, 'b_w_out': b_w_out,
            'c_w_in': c_w_in, 'c_q_norm': c_q_norm, 'c_kv_norm': c_kv_norm, 'c_w_uq': c_w_uq,
            'c_w_ukv': c_w_ukv, 'c_w_out': c_w_out,
            'd_w_in': d_w_in, 'd_ln_g': d_ln_g, 'd_ln_b': d_ln_b, 'd_w_s': d_w_s, 'd_b_s': d_b_s,
            'd_w_out': d_w_out}


def reference(x, pre_norm, post_norm, rel_bias,
              a_w_in, a_lam_re, a_lam_im, a_log_dt, a_b_re, a_b_im, a_c_re, a_c_im, a_d,
              a_w_glu, a_b_glu, a_w_out,
              b_w_in, b_sinks, b_w_out,
              c_w_in, c_q_norm, c_kv_norm, c_w_uq, c_w_ukv, c_w_out,
              d_w_in, d_ln_g, d_ln_b, d_w_s, d_b_s, d_w_out):
    for i in range(DEPTH):
        kind = i % N_MIXERS
        j = i // N_MIXERS
        h = rmsnorm(x, pre_norm[i])
        if kind == 0:
            y = s5_branch(h, a_w_in[j], a_lam_re[j], a_lam_im[j], a_log_dt[j], a_b_re[j], a_b_im[j],
                          a_c_re[j], a_c_im[j], a_d[j], a_w_glu[j], a_b_glu[j], a_w_out[j])
        elif kind == 1:
            y = swa_branch(h, b_w_in[j], b_sinks[j], b_w_out[j], rel_bias)
        elif kind == 2:
            y = mla_branch(h, c_w_in[j], c_q_norm[j], c_kv_norm[j], c_w_uq[j], c_w_ukv[j], c_w_out[j])
        else:
            y = sgu_branch(h, d_w_in[j], d_ln_g[j], d_ln_b[j], d_w_s[j], d_b_s[j], d_w_out[j])
        x = x + rmsnorm(y, post_norm[i])
    return x
```

```cpp
#include <hip/hip_runtime.h>
#include <cstdio>
#include <cstdint>

#define LAS __attribute__((address_space(3)))
#define GAS __attribute__((address_space(1)))
typedef unsigned short bf16;
typedef short bf16x8 __attribute__((ext_vector_type(8)));
typedef short bf16x4 __attribute__((ext_vector_type(4)));
typedef float f32x4 __attribute__((ext_vector_type(4)));
typedef float f32x2 __attribute__((ext_vector_type(2)));
typedef float f32x16 __attribute__((ext_vector_type(16)));
typedef unsigned u32x4 __attribute__((ext_vector_type(4)));
typedef unsigned u32x2 __attribute__((ext_vector_type(2)));

#ifndef MK_ONE_LAUNCH
#define MK_ONE_LAUNCH 1
#endif

constexpr int BATCH = 8, SEQ = 2048, DM = 1024, MTOK = BATCH * SEQ;
constexpr float EPS = 1e-6f;
constexpr float LOG2E = 1.4426950408889634f;
constexpr int NWAVES = 8, NTHREADS = 512;

__device__ __forceinline__ unsigned cvt_pk_bf16(float lo, float hi) { unsigned r; asm volatile("v_cvt_pk_bf16_f32 %0, %1, %2" : "=v"(r) : "v"(lo), "v"(hi)); return r; }
__device__ __forceinline__ float bf_lo(unsigned w) { return __uint_as_float(w << 16); }
__device__ __forceinline__ float bf_hi(unsigned w) { return __uint_as_float(w & 0xffff0000u); }
__device__ __forceinline__ float bf2f(bf16 h) { return __uint_as_float(((unsigned)h) << 16); }
__device__ __forceinline__ bf16 f2bf(float f) { return (bf16)(cvt_pk_bf16(f, 0.f) & 0xffffu); }
__device__ __forceinline__ u32x4 pack8(const float (&v)[8]) { u32x4 w; w.x = cvt_pk_bf16(v[0], v[1]); w.y = cvt_pk_bf16(v[2], v[3]); w.z = cvt_pk_bf16(v[4], v[5]); w.w = cvt_pk_bf16(v[6], v[7]); return w; }
__device__ __forceinline__ void unpack8(u32x4 w, float (&v)[8]) { v[0] = bf_lo(w.x); v[1] = bf_hi(w.x); v[2] = bf_lo(w.y); v[3] = bf_hi(w.y); v[4] = bf_lo(w.z); v[5] = bf_hi(w.z); v[6] = bf_lo(w.w); v[7] = bf_hi(w.w); }
__device__ __forceinline__ float fast_rcp(float x) { return __builtin_amdgcn_rcpf(x); }
__device__ __forceinline__ float fast_exp2(float x) { return __builtin_amdgcn_exp2f(x); }
__device__ __forceinline__ float sigmoidf_(float x) { return fast_rcp(1.f + fast_exp2(-x * LOG2E)); }
__device__ __forceinline__ float siluf_(float x) { return x * sigmoidf_(x); }
__device__ __forceinline__ float gelu_tanh(float x) { const float t = 1.5957691216057308f * (x + 0.044715f * x * x * x); return x * sigmoidf_(t); }
__device__ __forceinline__ int crow(int r, int hi) { return (r & 3) + 8 * (r >> 2) + 4 * hi; }
__device__ __forceinline__ float wave_sum(float v) {
#pragma unroll
    for (int o = 1; o < 64; o <<= 1) v += __shfl_xor(v, o);
    return v;
}

namespace pg8 {
constexpr int BM = 256, BK = 64, HALF = 128, HTB = HALF * BK * 2, STAGE_BYTES = 8 * HTB, NXCD = 8, WGM = 8;
__host__ __device__ __forceinline__ int lds_byte(int r, int c) { const int st = (r >> 4) * 2 + (c >> 5), rr = r & 15, cc = c & 31, ob = rr * 64 + cc * 2; return st * 1024 + (ob ^ (((ob >> 9) & 1) << 5)); }
__host__ __device__ __forceinline__ void stage_rc(int b, int& R, int& C) { const int st = b / 1024, sb = b % 1024, swz = sb ^ (((sb >> 9) & 1) << 5); R = (st >> 1) * 16 + swz / 64; C = (st & 1) * 32 + (swz % 64) / 2; }
__host__ __device__ __forceinline__ int perm32(int rho) { const int n = rho >> 4, i = rho & 15; return 8 * (i >> 2) + 4 * n + (i & 3); }

struct Unit { int pm, pn; };
struct Gemm { const bf16* A; const bf16* Bt; int K, lda, ldb; };

struct StaticOrder {
    int nM, nN, nwg, G, c;
    __device__ void init(int M, int N, int G_, int c_) { nM = M / BM; nN = N / BM; nwg = nM * nN; G = G_; c = c_; }
    __device__ bool next(int i, Unit& u) const {
        const long L = (long)i * G + c; if (L >= nwg) return false;
        int wgid = (int)L; { const int q = nwg / NXCD, r = nwg % NXCD, xcd = wgid % NXCD, off = wgid / NXCD; wgid = (xcd < r ? xcd * (q + 1) : r * (q + 1) + (xcd - r) * q) + off; }
        const int nig = WGM * nN, gid = wgid / nig, fm = gid * WGM, gsz = (nM - fm) < WGM ? (nM - fm) : WGM;
        u.pm = fm + ((wgid % nig) % gsz); u.pn = (wgid % nig) / gsz; return true;
    }
};
template <class Epi, class Sched, bool ALIGN_EPI = false, bool SP2 = true>
__device__ __forceinline__ void gemm_phase(LAS unsigned char* lds, const Gemm g, const Sched& S, const Epi& E) {
    const int tid = threadIdx.x, wid = __builtin_amdgcn_readfirstlane(tid >> 6), lane = tid & 63, wr = wid >> 2, wc = wid & 3, fr = lane & 15, fq = lane >> 4;
    int K = g.K; asm volatile("" : "+s"(K)); const int nt = K / BK;
    unsigned voffA[2], voffB[2];
#pragma unroll
    for (int i = 0; i < 2; ++i) { int R, C; stage_rc(tid * 16 + i * 8192, R, C); const int Rb = Epi::PERM ? ((R & ~31) + perm32(R & 31)) : R;
        voffA[i] = (unsigned)(R * g.lda + C) * 2u; voffB[i] = (unsigned)(Rb * g.ldb + C) * 2u; }
    const size_t kstep = (size_t)(BK * 2);
    const size_t hsA = (size_t)HALF * g.lda * 2, hsB = (size_t)HALF * g.ldb * 2;
    const size_t tsA = 2 * hsA, tsB = 2 * hsB;
    const unsigned ldsw = (unsigned)wid * 1024u;
    const int aoff = lds_byte(wr * 64 + fr, fq * 8), boff = lds_byte(wc * 32 + fr, fq * 8);
#define PG8_SA(b, h) (((b) * 2 + (h)) * HTB)
#define PG8_SB(b, h) ((4 + (b) * 2 + (h)) * HTB)
#define PG8_STAGE(bufoff, gbase, voff) do { _Pragma("unroll") for (int _i = 0; _i < 2; ++_i) \
        __builtin_amdgcn_global_load_lds((const unsigned*)((const char*)(gbase) + (voff)[_i]), (LAS unsigned*)(lds + (bufoff) + ldsw + _i * 8192), 16, 0, 0); } while (0)
#define PG8_LDA(dst, b, h) do { _Pragma("unroll") for (int m = 0; m < 4; ++m) _Pragma("unroll") for (int k = 0; k < 2; ++k) dst[m][k] = *(const LAS bf16x8*)(lds + PG8_SA(b, h) + aoff + m * 2048 + k * 1024); } while (0)
#define PG8_LDB(dst, b, h) do { _Pragma("unroll") for (int n = 0; n < 2; ++n) _Pragma("unroll") for (int k = 0; k < 2; ++k) dst[n][k] = *(const LAS bf16x8*)(lds + PG8_SB(b, h) + boff + n * 2048 + k * 1024); } while (0)
#define PG8_MMA(ai, bj, At, Bt) do { __builtin_amdgcn_s_setprio(1); _Pragma("unroll") for (int m = 0; m < 4; ++m) _Pragma("unroll") for (int n = 0; n < 2; ++n) _Pragma("unroll") for (int k = 0; k < 2; ++k) \
        acc[ai][bj][m][n] = __builtin_amdgcn_mfma_f32_16x16x32_bf16(Bt[n][k], At[m][k], acc[ai][bj][m][n], 0, 0, 0); __builtin_amdgcn_s_setprio(0); } while (0)
#define PG8_WAIT_V(n) asm volatile("s_waitcnt vmcnt(" #n ")" ::: "memory")
#define PG8_WAIT_L(n) asm volatile("s_waitcnt lgkmcnt(" #n ")" ::: "memory")
#define PG8_BAR __builtin_amdgcn_s_barrier()
#define PG8_SCHED __builtin_amdgcn_sched_barrier(0)
    Unit cur, nxt; int ui = 0;
    if (!S.next(0, cur)) return;
    f32x4 acc[2][2][4][2];
#pragma unroll
    for (int a = 0; a < 2; ++a)
#pragma unroll
        for (int b = 0; b < 2; ++b)
#pragma unroll
            for (int m = 0; m < 4; ++m)
#pragma unroll
                for (int n = 0; n < 2; ++n) acc[a][b][m][n] = (f32x4){0.f, 0.f, 0.f, 0.f};
    bf16x8 At[4][2], B0[2][2], B1[2][2];
    const char* cA = (const char*)g.A + (size_t)cur.pm * tsA; const char* cB = (const char*)g.Bt + (size_t)cur.pn * tsB;
    if constexpr (SP2) {
        PG8_STAGE(PG8_SB(0, 0), cB, voffB); PG8_STAGE(PG8_SB(0, 1), cB + hsB, voffB); PG8_STAGE(PG8_SA(0, 0), cA, voffA); PG8_STAGE(PG8_SA(0, 1), cA + hsA, voffA);
        if (wr == 1) PG8_BAR;
        PG8_WAIT_V(2); PG8_BAR;
        PG8_STAGE(PG8_SB(1, 0), cB + kstep, voffB); PG8_STAGE(PG8_SA(1, 0), cA + kstep, voffA); PG8_STAGE(PG8_SB(1, 1), cB + hsB + kstep, voffB);
        PG8_WAIT_V(6); PG8_BAR;
    } else {
        PG8_STAGE(PG8_SB(0, 0), cB, voffB); PG8_STAGE(PG8_SA(0, 0), cA, voffA); PG8_STAGE(PG8_SB(0, 1), cB + hsB, voffB); PG8_STAGE(PG8_SA(0, 1), cA + hsA, voffA);
        if (wr == 1) PG8_BAR;
        PG8_WAIT_V(4); PG8_BAR;
        PG8_STAGE(PG8_SB(1, 0), cB + kstep, voffB); PG8_STAGE(PG8_SA(1, 0), cA + kstep, voffA); PG8_STAGE(PG8_SB(1, 1), cB + hsB + kstep, voffB);
        PG8_WAIT_V(6); PG8_BAR;
    }
    for (;;) {
        const bool has_next = S.next(ui + 1, nxt);
        const char* nA = has_next ? (const char*)g.A + (size_t)nxt.pm * tsA : cA; const char* nB = has_next ? (const char*)g.Bt + (size_t)nxt.pn * tsB : cB;
        for (int t = 0; t < nt; t += 2) {
            const bool last = (t == nt - 2);
            const char* a1 = cA + (size_t)(t + 1) * kstep;
            const char* a2 = last ? nA : cA + (size_t)(t + 2) * kstep; const char* b2 = last ? nB : cB + (size_t)(t + 2) * kstep;
            const char* a3 = a2 + kstep; const char* b3 = b2 + kstep;
            if constexpr (SP2) {
            PG8_LDB(B0, 0, 0); PG8_LDB(B1, 0, 1); PG8_SCHED; PG8_LDA(At, 0, 0); PG8_STAGE(PG8_SA(1, 1), a1 + hsA, voffA);
            PG8_WAIT_V(8); PG8_WAIT_L(0); PG8_BAR; PG8_MMA(0, 0, At, B0); PG8_MMA(0, 1, At, B1); PG8_BAR; PG8_SCHED;
            PG8_LDA(At, 0, 1); PG8_STAGE(PG8_SB(0, 0), b2, voffB); PG8_STAGE(PG8_SB(0, 1), b2 + hsB, voffB); PG8_STAGE(PG8_SA(0, 0), a2, voffA);
            PG8_WAIT_V(8); PG8_WAIT_L(0); PG8_BAR; PG8_MMA(1, 0, At, B0); PG8_MMA(1, 1, At, B1); PG8_BAR; PG8_SCHED;
            PG8_LDB(B0, 1, 0); PG8_LDB(B1, 1, 1); PG8_SCHED; PG8_LDA(At, 1, 0); PG8_STAGE(PG8_SA(0, 1), a2 + hsA, voffA);
            PG8_WAIT_V(8); PG8_WAIT_L(0); PG8_BAR; PG8_MMA(0, 0, At, B0); PG8_MMA(0, 1, At, B1); PG8_BAR; PG8_SCHED;
            PG8_LDA(At, 1, 1); PG8_STAGE(PG8_SB(1, 0), b3, voffB); PG8_STAGE(PG8_SB(1, 1), b3 + hsB, voffB); PG8_STAGE(PG8_SA(1, 0), a3, voffA);
            PG8_WAIT_V(8); PG8_WAIT_L(0); PG8_BAR; PG8_MMA(1, 0, At, B0); PG8_MMA(1, 1, At, B1); PG8_BAR; PG8_SCHED;
            } else {
            PG8_LDB(B0, 0, 0); PG8_SCHED; PG8_LDA(At, 0, 0); PG8_STAGE(PG8_SA(1, 1), a1 + hsA, voffA);
            PG8_WAIT_L(8); PG8_BAR; PG8_WAIT_L(0); PG8_MMA(0, 0, At, B0); PG8_BAR; PG8_SCHED;
            PG8_LDB(B1, 0, 1); PG8_STAGE(PG8_SB(0, 0), b2, voffB);
            PG8_BAR; PG8_WAIT_L(0); PG8_MMA(0, 1, At, B1); PG8_BAR;
            PG8_LDA(At, 0, 1); PG8_STAGE(PG8_SA(0, 0), a2, voffA);
            PG8_BAR; PG8_WAIT_L(0); PG8_MMA(1, 0, At, B0); PG8_BAR; PG8_SCHED;
            PG8_STAGE(PG8_SB(0, 1), b2 + hsB, voffB);
            PG8_WAIT_V(6); PG8_BAR; PG8_MMA(1, 1, At, B1); PG8_BAR;
            PG8_LDB(B0, 1, 0); PG8_SCHED; PG8_LDA(At, 1, 0); PG8_STAGE(PG8_SA(0, 1), a2 + hsA, voffA);
            PG8_WAIT_L(8); PG8_BAR; PG8_WAIT_L(0); PG8_MMA(0, 0, At, B0); PG8_BAR; PG8_SCHED;
            PG8_LDB(B1, 1, 1); PG8_STAGE(PG8_SB(1, 0), b3, voffB);
            PG8_BAR; PG8_WAIT_L(0); PG8_MMA(0, 1, At, B1); PG8_BAR;
            PG8_LDA(At, 1, 1); PG8_STAGE(PG8_SA(1, 0), a3, voffA);
            PG8_BAR; PG8_WAIT_L(0); PG8_MMA(1, 0, At, B0); PG8_BAR; PG8_SCHED;
            PG8_STAGE(PG8_SB(1, 1), b3 + hsB, voffB);
            PG8_WAIT_V(6); PG8_BAR; PG8_MMA(1, 1, At, B1); PG8_BAR;
            }
        }
        if constexpr (ALIGN_EPI) { if (wr == 0) PG8_BAR; }
        if constexpr (!Epi::AFTER_DRAIN) { E(acc, cur, wr, wc, fr, fq); }
        if (!has_next) break;
#pragma unroll
        for (int a = 0; a < 2; ++a)
#pragma unroll
            for (int b = 0; b < 2; ++b)
#pragma unroll
                for (int m = 0; m < 4; ++m)
#pragma unroll
                    for (int n = 0; n < 2; ++n) acc[a][b][m][n] = (f32x4){0.f, 0.f, 0.f, 0.f};
        cur = nxt; cA = nA; cB = nB; ++ui;
        if constexpr (ALIGN_EPI) { if (wr == 1) PG8_BAR; }
    }
    PG8_WAIT_V(0);
    if constexpr (!ALIGN_EPI) { if (wr == 0) PG8_BAR; }
    PG8_BAR;
    if constexpr (Epi::AFTER_DRAIN) { E.fused(acc, cur, wr, wc, fr, fq, lds, wid, lane); }
#undef PG8_SA
#undef PG8_SB
#undef PG8_STAGE
#undef PG8_LDA
#undef PG8_LDB
#undef PG8_MMA
#undef PG8_WAIT_V
#undef PG8_WAIT_L
#undef PG8_BAR
#undef PG8_SCHED
}
}

#define XB_TMO      128
#define XB_XCNT(j)  (256  + 64 * (j))
#define XB_XSUB(j)  (1280 + 64 * (j))
#define XB_XGEN(j)  (2304 + 64 * (j))
#define XB_TOP      3328
#define XB_TOPGEN   3392
#define XCD_BAR_WORDS 3456
#define XB_SPIN_CAP (1u << 18)
__device__ __forceinline__ unsigned xb_ld(unsigned* p)              { return __hip_atomic_load(p, __ATOMIC_RELAXED, __HIP_MEMORY_SCOPE_AGENT); }
__device__ __forceinline__ unsigned xb_add(unsigned* p, unsigned v) { return __hip_atomic_fetch_add(p, v, __ATOMIC_RELAXED, __HIP_MEMORY_SCOPE_AGENT); }
__device__ __forceinline__ unsigned xb_xcc_id() { return (unsigned)__builtin_amdgcn_s_getreg((3 << 11) | 20) & 0xFu; }
#define XB_SPIN(cond, bar) do { unsigned _sp = 0; while (cond) { __builtin_amdgcn_s_sleep(1); \
    if ((++_sp & 255u) == 0u) { if (xb_ld(&(bar)[XB_TMO])) break; if (_sp > XB_SPIN_CAP) { atomicAdd(&(bar)[XB_TMO], 1u); break; } } } } while (0)
struct XcdBarrier { unsigned* bar; unsigned x; volatile LAS unsigned* st; };
__device__ __forceinline__ XcdBarrier xcd_barrier_post(unsigned* bar, volatile LAS unsigned* st) {
    XcdBarrier b; b.bar = bar; b.x = xb_xcc_id(); b.st = st;
    if (threadIdx.x == 0) (void)xb_add(&bar[XB_XCNT(b.x)], 1u);
    return b;
}
__device__ __forceinline__ void xcd_barrier_complete(unsigned* bar, unsigned x, unsigned& nloc, unsigned& nx) {
    const unsigned G = gridDim.x * gridDim.y * gridDim.z;
    unsigned sum, cnt, mine, sp = 0u;
    for (;;) {
        sum = 0u; cnt = 0u; mine = 0u;
#pragma unroll
        for (unsigned j = 0; j < 16; ++j) { const unsigned c = xb_ld(&bar[XB_XCNT(j)]); sum += c; cnt += (c > 0u) ? 1u : 0u; mine = (j == x) ? c : mine; }
        if (sum == G) break;
        __builtin_amdgcn_s_sleep(1);
        if ((++sp & 255u) == 0u) { if (xb_ld(&bar[XB_TMO])) break; if (sp > XB_SPIN_CAP) { atomicAdd(&bar[XB_TMO], 1u); break; } }
    }
    nloc = mine > 0u ? mine : 1u; nx = cnt > 0u ? cnt : 1u;
}
__device__ __forceinline__ void xcd_barrier(const XcdBarrier& b) {
    asm volatile("s_waitcnt vmcnt(0)" ::: "memory");
    __syncthreads();
    if (threadIdx.x == 0) {
        unsigned* bar = b.bar;
        __builtin_amdgcn_s_waitcnt(0);
        unsigned nloc = b.st[0], nx = b.st[1];
        if (nloc == 0u) { xcd_barrier_complete(bar, b.x, nloc, nx); b.st[0] = nloc; b.st[1] = nx; }
        const unsigned old = xb_add(&bar[XB_XSUB(b.x)], 1u);
        const unsigned gen = old / nloc;
        if (old + 1u == (gen + 1u) * nloc) {
            __builtin_amdgcn_fence(__ATOMIC_RELEASE, "agent");
            asm volatile("s_waitcnt vmcnt(0)" ::: "memory");
            const unsigned og = xb_add(&bar[XB_TOP], 1u);
            const unsigned tg = og / nx;
            if (og + 1u == (tg + 1u) * nx) xb_add(&bar[XB_TOPGEN], 1u);
            else XB_SPIN(xb_ld(&bar[XB_TOPGEN]) == tg, bar);
            __builtin_amdgcn_fence(__ATOMIC_ACQUIRE, "agent");
            xb_add(&bar[XB_XGEN(b.x)], 1u);
            asm volatile("s_waitcnt vmcnt(0)" ::: "memory");
        } else {
            XB_SPIN(xb_ld(&bar[XB_XGEN(b.x)]) == gen, bar);
            __builtin_amdgcn_fence(__ATOMIC_ACQUIRE, "agent");
            asm volatile("s_waitcnt vmcnt(0)" ::: "memory");
        }
    }
    __syncthreads();
}

constexpr size_t MiB = 1u << 20;
constexpr size_t WS_CTL = 0, CTL_ZERO_BYTES = 64 * 1024;
constexpr size_t WS_TAB   = 1 * MiB;
constexpr size_t TAB_ROPE = WS_TAB;
constexpr size_t TAB_BIAS = WS_TAB + 256 * 1024;
constexpr size_t TAB_A32  = WS_TAB + 272 * 1024;
constexpr size_t TAB_WS   = WS_TAB + 512 * 1024;
constexpr size_t TAB_S1   = 2 * MiB;
constexpr size_t TAB_S2   = 4 * MiB;
constexpr size_t WS_W     = 8 * MiB;
constexpr size_t W_A_IN = WS_W, W_A_GLU = W_A_IN + 4 * MiB, W_A_OUT = W_A_GLU + 2 * MiB, W_B_IN = W_A_OUT + 2 * MiB, W_B_OUT = W_B_IN + 4608 * 1024,
                 W_C_IN = W_B_OUT + 2 * MiB, W_C_ROPE = W_C_IN + 4 * MiB, W_C_UQ = W_C_ROPE + 64 * 1024, W_C_UKV = W_C_UQ + 2304 * 1024, W_C_OUT = W_C_UKV + 1 * MiB,
                 W_D_IN = W_C_OUT + 2 * MiB, W_D_OUT = W_D_IN + 6 * MiB, W_END = W_D_OUT + 2 * MiB;
static_assert(W_END <= 40 * MiB, "weights region");
constexpr size_t WS_XN = 40 * MiB;
constexpr size_t WS_Z  = 72 * MiB;
constexpr size_t WS_GT = 104 * MiB;
constexpr size_t WS_Y  = 136 * MiB;
constexpr size_t WS_L  = 168 * MiB;
constexpr size_t S5_BST = WS_L, S5_B2 = WS_L + 8 * MiB, S5_A2 = WS_L + 48 * MiB;
constexpr size_t SW_Q = WS_L, SW_KV = WS_L + 32 * MiB;
constexpr size_t ML_CQ = WS_L, ML_CKV = WS_L + 24 * MiB, ML_KR = WS_L + 32 * MiB, ML_Q = WS_L + 33 * MiB;
constexpr size_t ML_KN = WS_Y, ML_V = WS_XN;
constexpr size_t SG_U = WS_L, SG_V = WS_L + 32 * MiB;
constexpr size_t WS_END = 256 * MiB;
static_assert(S5_A2 + 40 * MiB <= WS_END && ML_Q + 48 * MiB <= WS_END, "ws map");
constexpr int CW_BAR = 4096;

constexpr int RING_BYTES = 131072, LDSCTL_OFF = RING_BYTES, LDS_BYTES = 147456;

struct Args { const float* in[31]; float* out; unsigned char* ws; int ph_lo, ph_hi; };

struct Ctx { LAS unsigned char* lds; int tid, lane, wave, vcu, G; };

#ifndef WT_STORES
#define WT_STORES 0
#endif
__device__ __forceinline__ void st16(bf16* p, u32x4 w) {
#if WT_STORES
    asm volatile("global_store_dwordx4 %0, %1, off sc1\n\ts_nop 1" :: "v"(p), "v"(w) : "memory");
#else
    *(u32x4*)p = w;
#endif
}
__device__ __forceinline__ void st16f(float* p, f32x4 w) {
#if WT_STORES
    asm volatile("global_store_dwordx4 %0, %1, off sc1\n\ts_nop 1" :: "v"(p), "v"(w) : "memory");
#else
    *(f32x4*)p = w;
#endif
}
__device__ __forceinline__ void st8(bf16* p, u32x2 w) {
#if WT_STORES
    asm volatile("global_store_dwordx2 %0, %1, off sc1\n\ts_nop 1" :: "v"(p), "v"(w) : "memory");
#else
    *(u32x2*)p = w;
#endif
}
__device__ __forceinline__ u32x4 ld16(const bf16* p) { return *(const u32x4*)p; }

template <class Op> struct Epi8 {
    static constexpr bool PERM = true, AFTER_DRAIN = false;
    Op op;
    __device__ __forceinline__ void operator()(const f32x4 (&acc)[2][2][4][2], const pg8::Unit& u, int wr, int wc, int fr, int fq) const {
        const int row0 = u.pm * 256 + wr * 64 + fr, col0 = u.pn * 256 + wc * 32 + 8 * fq;
#pragma unroll
        for (int ai = 0; ai < 2; ++ai)
#pragma unroll
            for (int m = 0; m < 4; ++m) {
                const int row = row0 + ai * 128 + m * 16;
#pragma unroll
                for (int bj = 0; bj < 2; ++bj) {
                    const int col = col0 + bj * 128;
                    float v[8];
#pragma unroll
                    for (int j = 0; j < 4; ++j) { v[j] = acc[ai][bj][m][0][j]; v[4 + j] = acc[ai][bj][m][1][j]; }
                    op(row, col, v, fq);
                }
            }
    }
};

struct OpAin {
    bf16* A2; bf16* zb;
    __device__ __forceinline__ void operator()(int row, int col, float (&v)[8], int) const {
        if (col < 1024) { const int g = col >> 4, h0 = col & 15; st16(A2 + ((size_t)(g * 512 + (row >> 5))) * 640 + (row & 31) * 16 + h0, pack8(v)); }
        else { float s[8];
#pragma unroll
            for (int j = 0; j < 8; ++j) s[j] = siluf_(v[j]);
            st16(zb + (size_t)row * 1024 + (col - 1024), pack8(s)); }
    }
};
struct OpAy {
    const bf16* A2; const float* dsk; bf16* yact;
    __device__ __forceinline__ void operator()(int row, int col, float (&v)[8], int) const {
        const int g = row >> 9, rr = row & 511, cc = col & 511;
        const int token = (rr >> 6) * 2048 + (rr & 63) * 32 + (cc >> 4), ch = g * 16 + (cc & 15);
        float u8[8]; unpack8(ld16(A2 + (size_t)row * 640 + cc), u8);
        const f32x4 d0 = *(const f32x4*)(dsk + ch), d1 = *(const f32x4*)(dsk + ch + 4);
        float o[8];
#pragma unroll
        for (int j = 0; j < 4; ++j) { o[j] = gelu_tanh(v[j] + d0[j] * u8[j]); o[4 + j] = gelu_tanh(v[4 + j] + d1[j] * u8[4 + j]); }
        st16(yact + (size_t)token * 1024 + ch, pack8(o));
    }
};
struct OpAglu {
    const bf16* yact; const bf16* zb; const float* bglu; bf16* gt;
    __device__ __forceinline__ void operator()(int row, int col, float (&v)[8], int) const {
        const size_t off = (size_t)row * 1024 + col;
        float y[8], z[8]; unpack8(ld16(yact + off), y); unpack8(ld16(zb + off), z);
        const f32x4 b0 = *(const f32x4*)(bglu + col), b1 = *(const f32x4*)(bglu + col + 4);
        float o[8];
#pragma unroll
        for (int j = 0; j < 4; ++j) { o[j] = y[j] * sigmoidf_(v[j] + b0[j]) * z[j]; o[4 + j] = y[4 + j] * sigmoidf_(v[4 + j] + b1[j]) * z[4 + j]; }
        st16(gt + off, pack8(o));
    }
};
struct OpOut {
    bf16* Y;
    __device__ __forceinline__ void operator()(int row, int col, float (&v)[8], int) const { st16(Y + (size_t)row * 1024 + col, pack8(v)); }
};
constexpr float QS_SWA = 0.125f * LOG2E;
struct OpBin {
    bf16* q; bf16* kv; bf16* zb;
    __device__ __forceinline__ void operator()(int row, int col, float (&v)[8], int) const {
        if (col < 1024) { float s[8];
#pragma unroll
            for (int j = 0; j < 8; ++j) s[j] = v[j] * QS_SWA;
            st16(q + (size_t)row * 1024 + col, pack8(s)); }
        else if (col < 1280) { st16(kv + (size_t)row * 256 + (col - 1024), pack8(v)); }
        else { float s[8];
#pragma unroll
            for (int j = 0; j < 8; ++j) s[j] = siluf_(v[j]);
            st16(zb + (size_t)row * 1024 + (col - 1280), pack8(s)); }
    }
};
struct OpCin {
    bf16* cq; bf16* ckv; bf16* zb; float* ssq;
    __device__ __forceinline__ void operator()(int row, int col, float (&v)[8], int fq) const {
        if (col < 1024) {
            float s = 0.f;
#pragma unroll
            for (int j = 0; j < 8; ++j) s += v[j] * v[j];
            s += __shfl_xor(s, 16); s += __shfl_xor(s, 32);
            if (fq == 0) ssq[(size_t)(col >> 5) * MTOK + row] = s;
            if (col < 768) st16(cq + (size_t)row * 768 + col, pack8(v)); else st16(ckv + (size_t)row * 256 + (col - 768), pack8(v));
        } else { float s[8];
#pragma unroll
            for (int j = 0; j < 8; ++j) s[j] = siluf_(v[j]);
            st16(zb + (size_t)row * 1024 + (col - 1024), pack8(s)); }
    }
};
struct OpDin {
    bf16* ub; bf16* vb; bf16* zb; float* ssum; float* ssq;
    __device__ __forceinline__ void operator()(int row, int col, float (&v)[8], int fq) const {
        float s[8];
        if (col < 2048) {
#pragma unroll
            for (int j = 0; j < 8; ++j) s[j] = gelu_tanh(v[j]);
            if (col < 1024) st16(ub + (size_t)row * 1024 + col, pack8(s));
            else {
                float a = 0.f, q = 0.f;
#pragma unroll
                for (int j = 0; j < 8; ++j) { a += s[j]; q += s[j] * s[j]; }
                a += __shfl_xor(a, 16); a += __shfl_xor(a, 32); q += __shfl_xor(q, 16); q += __shfl_xor(q, 32);
                if (fq == 0) { const size_t so = (size_t)((col - 1024) >> 5) * MTOK + row; ssum[so] = a; ssq[so] = q; }
                st16(vb + (size_t)row * 1024 + (col - 1024), pack8(s));
            }
        } else {
#pragma unroll
            for (int j = 0; j < 8; ++j) s[j] = siluf_(v[j]);
            st16(zb + (size_t)row * 1024 + (col - 2048), pack8(s));
        }
    }
};

constexpr float QS_MLA = 0.10206207261596577f * LOG2E;
struct OpQ {
    bf16* Q;
    __device__ __forceinline__ void operator()(int row, int col, float (&v)[8], int) const { st16(Q + (size_t)row * 1536 + col, pack8(v)); }
};
struct EpiCukv {
    static constexpr bool PERM = true, AFTER_DRAIN = false;
    const float* ssq; bf16* KN; bf16* V;
    __device__ __forceinline__ void operator()(const f32x4 (&acc)[2][2][4][2], const pg8::Unit& u, int wr, int wc, int fr, int fq) const {
        const int row0 = u.pm * 256 + wr * 64 + fr, col0 = u.pn * 256 + wc * 32 + 8 * fq;
#pragma unroll
        for (int ai = 0; ai < 2; ++ai)
#pragma unroll
            for (int m = 0; m < 4; ++m) {
                const int row = row0 + ai * 128 + m * 16;
                float s = ssq[(size_t)(24 + fq * 2) * MTOK + row] + ssq[(size_t)(24 + fq * 2 + 1) * MTOK + row];
                s += __shfl_xor(s, 16); s += __shfl_xor(s, 32);
                const float rs = rsqrtf(s * (1.f / 256.f) + EPS);
#pragma unroll
                for (int bj = 0; bj < 2; ++bj) {
                    const int col = col0 + bj * 128;
                    float v[8];
#pragma unroll
                    for (int j = 0; j < 4; ++j) { v[j] = acc[ai][bj][m][0][j] * rs; v[4 + j] = acc[ai][bj][m][1][j] * rs; }
                    if (col < 1024) st16(KN + (size_t)row * 1024 + col, pack8(v)); else st16(V + (size_t)row * 1024 + (col - 1024), pack8(v));
                }
            }
    }
};
struct EpiAscan {
    static constexpr bool PERM = false, AFTER_DRAIN = true;
    const float* a32; bf16* A2;
    __device__ __forceinline__ void fused(const f32x4 (&acc)[2][2][4][2], const pg8::Unit& u, int wr, int wc, int fr, int fq, LAS unsigned char* lds, int wid, int lane) const {
        const int g = u.pm >> 1, rm = u.pm & 1; const bool sel = (g & 1) != 0;
        LAS float* T = (LAS float*)lds;
#pragma unroll
        for (int ai = 0; ai < 2; ++ai)
#pragma unroll
            for (int m = 0; m < 4; ++m)
#pragma unroll
                for (int n = 0; n < 2; ++n) {
                    const int rl = ai * 128 + wr * 64 + m * 16 + fr, c = wc * 32 + n * 16 + 4 * fq;
                    const f32x4 v = sel ? acc[ai][1][m][n] : acc[ai][0][m][n];
                    *(LAS f32x4*)(T + rl * 128 + c) = v;
                }
        __syncthreads();
        const int tid = wid * 64 + lane;
        if (tid < 256) {
            const int bl = tid >> 6, p = tid & 63;
            const float are = a32[(g * 64 + p) * 2], aim = a32[(g * 64 + p) * 2 + 1];
            float sre = 0.f, sim = 0.f;
            bf16* dst = A2 + ((size_t)(g * 512 + (rm * 4 + bl) * 64)) * 640 + 512 + p;
            const LAS float* src = T + (bl * 64) * 128 + p;
            for (int c = 0; c < 64; ++c) {
                dst[(size_t)c * 640] = f2bf(sre); dst[(size_t)c * 640 + 64] = f2bf(sim);
                const float xre = src[c * 128], xim = src[c * 128 + 64];
                const float nre = are * sre - aim * sim + xre, nim = are * sim + aim * sre + xim;
                sre = nre; sim = nim;
            }
        }
        __syncthreads();
    }
};
struct OrderS5a { int vcu, G; __device__ bool next(int i, pg8::Unit& u) const { const int L = i * G + vcu; if (L >= 128) return false; const int g = L >> 1; u.pm = 2 * g + (L & 1); u.pn = g >> 1; return true; } };
struct OrderS5b { int vcu, G; __device__ bool next(int i, pg8::Unit& u) const { const int L = i * G + vcu; if (L >= 256) return false; const int g = L >> 2; u.pm = 2 * g + ((L >> 1) & 1); u.pn = 2 * g + (L & 1); return true; } };

struct TItem { const float* W; const float* gain; bf16* WT; int ldw, K, src_col0, dst_row0, kb; };
__device__ __forceinline__ void titem_load(const TItem& t, int lane, f32x4 (&w)[8], float (&gv)[8]) {
    const int k0 = 64 * t.kb, c4 = (lane & 7) * 4, kr = lane >> 3;
#pragma unroll
    for (int i = 0; i < 8; ++i) { w[i] = *(const f32x4*)(t.W + (size_t)(k0 + kr + 8 * i) * t.ldw + t.src_col0 + c4); gv[i] = t.gain ? t.gain[k0 + kr + 8 * i] : 1.f; }
}
__device__ __forceinline__ void titem_store(const TItem& t, int lane, const f32x4 (&w)[8], const float (&gv)[8], LAS float* scr) {
    const int k0 = 64 * t.kb, c4 = (lane & 7) * 4, kr = lane >> 3;
#pragma unroll
    for (int i = 0; i < 8; ++i) { LAS float* d = scr + (kr + 8 * i) * 33 + c4; d[0] = w[i].x * gv[i]; d[1] = w[i].y * gv[i]; d[2] = w[i].z * gv[i]; d[3] = w[i].w * gv[i]; }
    asm volatile("s_waitcnt lgkmcnt(0)" ::: "memory");
    const int c = lane & 7;
#pragma unroll
    for (int j = 0; j < 4; ++j) { const int n = (lane >> 3) + 8 * j; const LAS float* s = scr + (8 * c) * 33 + n;
        u32x4 o; o.x = cvt_pk_bf16(s[0 * 33], s[1 * 33]); o.y = cvt_pk_bf16(s[2 * 33], s[3 * 33]); o.z = cvt_pk_bf16(s[4 * 33], s[5 * 33]); o.w = cvt_pk_bf16(s[6 * 33], s[7 * 33]);
        *(u32x4*)(t.WT + (size_t)(t.dst_row0 + n) * t.K + k0 + 8 * c) = o; }
    asm volatile("s_waitcnt lgkmcnt(0)" ::: "memory");
}
__device__ __forceinline__ void rms_rows2_to_bf16(const float* xa, const float* xb, bf16* oa, bf16* ob, int lane) {
    const f32x4* xr0 = (const f32x4*)xa + lane; const f32x4* xr1 = (const f32x4*)xb + lane;
    f32x4 v[4], w[4]; float s = 0.f, s2 = 0.f;
#pragma unroll
    for (int j = 0; j < 4; ++j) { v[j] = xr0[64 * j]; w[j] = xr1[64 * j]; }
#pragma unroll
    for (int j = 0; j < 4; ++j) { s += (v[j].x * v[j].x + v[j].y * v[j].y) + (v[j].z * v[j].z + v[j].w * v[j].w); s2 += (w[j].x * w[j].x + w[j].y * w[j].y) + (w[j].z * w[j].z + w[j].w * w[j].w); }
    const float r = rsqrtf(wave_sum(s) * (1.f / 1024.f) + EPS), r2 = rsqrtf(wave_sum(s2) * (1.f / 1024.f) + EPS);
    u32x2* o8 = (u32x2*)oa + lane; u32x2* p8 = (u32x2*)ob + lane;
#pragma unroll
    for (int j = 0; j < 4; ++j) { u32x2 q; q.x = cvt_pk_bf16(v[j].x * r, v[j].y * r); q.y = cvt_pk_bf16(v[j].z * r, v[j].w * r); o8[64 * j] = q;
        u32x2 q2; q2.x = cvt_pk_bf16(w[j].x * r2, w[j].y * r2); q2.y = cvt_pk_bf16(w[j].z * r2, w[j].w * r2); p8[64 * j] = q2; }
}

constexpr int NI0 = 16 * 64, NI1 = 16 * 32, NI3 = 16 * 72, NI5 = 16 * 64, NI6 = 16, NI7 = 12 * 48, NI8 = 4 * 64, NI10 = 16 * 96;
constexpr int NITEMS = NI0 + NI1 * 2 + NI3 + NI1 + NI5 + NI6 + NI7 + NI8 + NI1 + NI10 + NI1;
__device__ __forceinline__ TItem titem_decode(const __attribute__((address_space(4))) Args& a, unsigned char* ws, int r) {
    TItem t;
#define TI(W_, LDW_, K_, SC_, G_, WT_, DR_, KB_) do { t.W = (W_); t.ldw = (LDW_); t.K = (K_); t.src_col0 = (SC_); t.gain = (G_); t.WT = (bf16*)(ws + (WT_)); t.dst_row0 = (DR_); t.kb = (KB_); return t; } while (0)
    if (r < NI0) { const int nb = 64, kb = r / nb, n0 = (r % nb) * 32; TI(a.in[4], 2048, 1024, n0, a.in[1], W_A_IN, n0, kb); } r -= NI0;
    if (r < NI1) { const int nb = 32, kb = r / nb, n0 = (r % nb) * 32; TI(a.in[13], 1024, 1024, n0, nullptr, W_A_GLU, n0, kb); } r -= NI1;
    if (r < NI1) { const int nb = 32, kb = r / nb, n0 = (r % nb) * 32; TI(a.in[15], 1024, 1024, n0, nullptr, W_A_OUT, n0, kb); } r -= NI1;
    if (r < NI3) { const int nb = 72, kb = r / nb, n0 = (r % nb) * 32; TI(a.in[16], 2304, 1024, n0, a.in[1] + 1024, W_B_IN, n0, kb); } r -= NI3;
    if (r < NI1) { const int nb = 32, kb = r / nb, n0 = (r % nb) * 32; TI(a.in[18], 1024, 1024, n0, nullptr, W_B_OUT, n0, kb); } r -= NI1;
    if (r < NI5) { const int nb = 64, kb = r / nb, n0 = (r % nb) * 32; TI(a.in[19], 2080, 1024, n0 < 1024 ? n0 : n0 + 32, a.in[1] + 2048, W_C_IN, n0, kb); } r -= NI5;
    if (r < NI6) { TI(a.in[19], 2080, 1024, 1024, a.in[1] + 2048, W_C_ROPE, 0, r); } r -= NI6;
    if (r < NI7) { const int nb = 48, kb = r / nb, n0 = (r % nb) * 32; TI(a.in[22], 1536, 768, n0, a.in[20], W_C_UQ, n0, kb); } r -= NI7;
    if (r < NI8) { const int nb = 64, kb = r / nb, n0 = (r % nb) * 32; const int sc = n0 < 1024 ? (n0 >> 6) * 128 + (n0 & 63) : ((n0 - 1024) >> 6) * 128 + 64 + (n0 & 63); TI(a.in[23], 2048, 256, sc, a.in[21], W_C_UKV, n0, kb); } r -= NI8;
    if (r < NI1) { const int nb = 32, kb = r / nb, n0 = (r % nb) * 32; TI(a.in[24], 1024, 1024, n0, nullptr, W_C_OUT, n0, kb); } r -= NI1;
    if (r < NI10) { const int nb = 96, kb = r / nb, n0 = (r % nb) * 32; TI(a.in[25], 3072, 1024, n0, a.in[1] + 3072, W_D_IN, n0, kb); } r -= NI10;
    { const int nb = 32, kb = r / nb, n0 = (r % nb) * 32; TI(a.in[30], 1024, 1024, n0, nullptr, W_D_OUT, n0, kb); }
#undef TI
}
__device__ __forceinline__ void prologue(const __attribute__((address_space(4))) Args* ap_, const Ctx& C) {
    const __attribute__((address_space(4))) Args& a = *ap_;
    unsigned char* ws = a.ws;
    LAS float* scr = (LAS float*)(C.lds + C.wave * 16384);
    const int gw = C.vcu * NWAVES + C.wave, NGW = C.G * NWAVES;
    for (int it = gw; it < NITEMS; it += 2 * NGW) {
        const TItem t0 = titem_decode(a, ws, it);
        const bool two = (it + NGW) < NITEMS;
        const TItem t1 = titem_decode(a, ws, two ? it + NGW : it);
        f32x4 w0[8], w1[8]; float g0[8], g1[8];
        titem_load(t0, C.lane, w0, g0); titem_load(t1, C.lane, w1, g1);
        titem_store(t0, C.lane, w0, g0, scr);
        if (two) titem_store(t1, C.lane, w1, g1, scr);
    }
}
__device__ __forceinline__ void prologue_tables(const __attribute__((address_space(4))) Args* ap_, const Ctx& C) {
    const __attribute__((address_space(4))) Args& a = *ap_;
    unsigned char* ws = a.ws;
    const int gw = C.vcu * NWAVES + C.wave, NGW = C.G * NWAVES;
    for (int m = gw; m < MTOK; m += 2 * NGW) { const int m2 = (m + NGW < MTOK) ? m + NGW : m;
        rms_rows2_to_bf16(a.in[0] + (size_t)m * 1024, a.in[0] + (size_t)m2 * 1024, (bf16*)(ws + WS_XN) + (size_t)m * 1024, (bf16*)(ws + WS_XN) + (size_t)m2 * 1024, C.lane); }
    {
        const int gt = C.vcu * NTHREADS + C.tid, NGT = C.G * NTHREADS;
        float* rc = (float*)(ws + TAB_ROPE); float* rsn = rc + 2048 * 16;
        for (int i = gt; i < 2048 * 16; i += NGT) {
            const int pos = i >> 4, j = i & 15;
            const float inv = exp2f(-(float)(2 * j) * (13.287712379549449f / 32.f));
            const float ang = (float)pos * inv;
            rc[i] = cosf(ang); rsn[i] = sinf(ang);
        }
        float* bt = (float*)(ws + TAB_BIAS);
        for (int i = gt; i < 16 * 128; i += NGT) {
            const int h = i >> 7, d = i & 127;
            int bk = d;
            if (d >= 16) { const float lg = logf((float)d / 16.f) / 2.0794415416798357f * 16.f; bk = 16 + (int)lg; if (bk > 31) bk = 31; }
            bt[i] = a.in[3][bk * 16 + h] * LOG2E;
        }
        bf16* wsb = (bf16*)(ws + TAB_WS);
        for (int i = gt; i < 16 * 128 * 16; i += NGT) {
            const int t = (i >> 4) & 127, s0 = (i & 15) * 8;
            const f32x4 w0 = *(const f32x4*)(a.in[28] + (size_t)i * 8), w1 = *(const f32x4*)(a.in[28] + (size_t)i * 8 + 4);
            float v[8] = {w0.x, w0.y, w0.z, w0.w, w1.x, w1.y, w1.z, w1.w};
#pragma unroll
            for (int j = 0; j < 8; ++j) if (s0 + j > t) v[j] = 0.f;
            st16(wsb + (size_t)i * 8, pack8(v));
        }
    }
}
__device__ __forceinline__ void prologue_s5(const __attribute__((address_space(4))) Args* ap_, const Ctx& C) {
    const __attribute__((address_space(4))) Args& a = *ap_;
    unsigned char* ws = a.ws;
    __syncthreads();
    LAS float* pw = (LAS float*)C.lds;
    LAS float* Bb = pw + 33 * 64 * 2;
    LAS float* Cc = Bb + 64 * 16 * 2;
    LAS float* Kq = Cc + 4 * 64 * 2;
    LAS float* Fz = Kq + 32 * 4 * 16;
    for (int bt = C.vcu; bt < 256; bt += C.G) {
        const int g = bt >> 2, q = bt & 3;
        const float dt = expf(a.in[7][g]);
        for (int i = C.tid; i < 33 * 64; i += NTHREADS) {
            const int tau = i >> 6, p = i & 63;
            const float lr = a.in[5][g * 64 + p], li = a.in[6][g * 64 + p];
            const float mag = fast_exp2(lr * dt * (float)tau * LOG2E);
            float rev = li * dt * (float)tau * 0.15915494309189535f; rev = rev - floorf(rev);
            pw[i * 2] = mag * __builtin_amdgcn_cosf(rev); pw[i * 2 + 1] = mag * __builtin_amdgcn_sinf(rev);
        }
        if (C.tid < 64) {
            const int p = C.tid;
            const float lr = a.in[5][g * 64 + p], li = a.in[6][g * 64 + p];
            const float zr = lr * dt, zi = li * dt;
            const float em1 = expm1f(zr), sh = sinf(0.5f * zi), cm1 = -2.f * sh * sh, sn = sinf(zi);
            const float nr = em1 * (1.f + cm1) + cm1, ni = (1.f + em1) * sn;
            const float den = lr * lr + li * li;
            Fz[p * 2] = (nr * lr + ni * li) / den; Fz[p * 2 + 1] = (ni * lr - nr * li) / den;
        }
        for (int i = C.tid; i < 4 * 64; i += NTHREADS) {
            const int hl = i >> 6, p = i & 63;
            Cc[i * 2] = a.in[10][(size_t)g * 1024 + (4 * q + hl) * 64 + p]; Cc[i * 2 + 1] = a.in[11][(size_t)g * 1024 + (4 * q + hl) * 64 + p];
        }
        __syncthreads();
        for (int i = C.tid; i < 64 * 16; i += NTHREADS) {
            const int p = i >> 4;
            const float fre = Fz[p * 2], fim = Fz[p * 2 + 1];
            const float br = a.in[8][(size_t)g * 1024 + i], bi = a.in[9][(size_t)g * 1024 + i];
            Bb[i * 2] = fre * br - fim * bi; Bb[i * 2 + 1] = fre * bi + fim * br;
        }
        __syncthreads();
        for (int i = C.tid; i < 32 * 64; i += NTHREADS) {
            const int tau = i >> 6, hl = (i >> 4) & 3, h = i & 15;
            float s = 0.f;
#pragma unroll 8
            for (int p = 0; p < 64; ++p) {
                const f32x2 cc = *(const LAS f32x2*)(Cc + (hl * 64 + p) * 2), aa = *(const LAS f32x2*)(pw + (tau * 64 + p) * 2), bb = *(const LAS f32x2*)(Bb + (p * 16 + h) * 2);
                const float tr = cc.x * aa.x - cc.y * aa.y, ti = cc.x * aa.y + cc.y * aa.x;
                s += tr * bb.x - ti * bb.y;
            }
            Kq[i] = s;
        }
        __syncthreads();
        bf16* B2 = (bf16*)(ws + S5_B2) + (size_t)(g * 512) * 640;
        for (int i = C.tid; i < 128 * 80; i += NTHREADS) {
            const int rl = i / 80, ch = i % 80, j = rl >> 2, hl = rl & 3;
            float v[8];
            if (ch < 64) { const int ii = ch >> 1, h0 = (ch & 1) * 8;
                if (ii <= j) { const LAS float* kp = Kq + ((j - ii) * 4 + hl) * 16 + h0; const f32x4 k0 = *(const LAS f32x4*)kp, k1 = *(const LAS f32x4*)(kp + 4);
                    v[0] = k0.x; v[1] = k0.y; v[2] = k0.z; v[3] = k0.w; v[4] = k1.x; v[5] = k1.y; v[6] = k1.z; v[7] = k1.w; }
                else {
#pragma unroll
                    for (int e = 0; e < 8; ++e) v[e] = 0.f; }
            } else { const int p0 = ((ch - 64) * 8) & 63; const bool im = ch >= 72;
#pragma unroll
                for (int e = 0; e < 8; ++e) { const int p = p0 + e; const float cr = Cc[(hl * 64 + p) * 2], ci = Cc[(hl * 64 + p) * 2 + 1], ar = pw[((j + 1) * 64 + p) * 2], ai = pw[((j + 1) * 64 + p) * 2 + 1];
                    v[e] = im ? -(cr * ai + ci * ar) : (cr * ar - ci * ai); }
            }
            st16(B2 + (size_t)(j * 16 + 4 * q + hl) * 640 + ch * 8, pack8(v));
        }
        bf16* Bs = (bf16*)(ws + S5_BST) + (size_t)(g * 128 + q * 32) * 512;
        for (int i = C.tid; i < 32 * 64; i += NTHREADS) {
            const int r = q * 32 + (i >> 6), ch = i & 63, p = r & 63, ii = ch >> 1, h0 = (ch & 1) * 8;
            const float ar = pw[((31 - ii) * 64 + p) * 2], ai = pw[((31 - ii) * 64 + p) * 2 + 1];
            float v[8];
#pragma unroll
            for (int e = 0; e < 8; ++e) { const float br = Bb[(p * 16 + h0 + e) * 2], bi = Bb[(p * 16 + h0 + e) * 2 + 1]; v[e] = r < 64 ? (ar * br - ai * bi) : (ar * bi + ai * br); }
            st16(Bs + (size_t)(i >> 6) * 512 + ch * 8, pack8(v));
        }
        if (q == 0 && C.tid < 64) { float* a32 = (float*)(ws + TAB_A32); a32[(g * 64 + C.tid) * 2] = pw[(32 * 64 + C.tid) * 2]; a32[(g * 64 + C.tid) * 2 + 1] = pw[(32 * 64 + C.tid) * 2 + 1]; }
        __syncthreads();
    }
}

__device__ __forceinline__ void row_phase(const Ctx& C, const bf16* Y, const float* xin, float* xout, const float* gpost, bf16* XN, bool make_xn) {
    const int gw = C.vcu * NWAVES + C.wave, NGW = C.G * NWAVES;
    f32x4 gp[4];
#pragma unroll
    for (int j = 0; j < 4; ++j) gp[j] = *((const f32x4*)gpost + C.lane + 64 * j);
    for (int m = gw; m < MTOK; m += NGW) {
        const u32x2* yr = (const u32x2*)(Y + (size_t)m * 1024) + C.lane;
        const f32x4* xr = (const f32x4*)(xin + (size_t)m * 1024) + C.lane;
        f32x4 y[4], x[4]; float s = 0.f;
#pragma unroll
        for (int j = 0; j < 4; ++j) { const u32x2 w = yr[64 * j]; y[j] = (f32x4){bf_lo(w.x), bf_hi(w.x), bf_lo(w.y), bf_hi(w.y)}; x[j] = xr[64 * j];
            s += (y[j].x * y[j].x + y[j].y * y[j].y) + (y[j].z * y[j].z + y[j].w * y[j].w); }
        const float r = rsqrtf(wave_sum(s) * (1.f / 1024.f) + EPS);
        float s2 = 0.f;
#pragma unroll
        for (int j = 0; j < 4; ++j) { x[j] = x[j] + y[j] * r * gp[j]; s2 += (x[j].x * x[j].x + x[j].y * x[j].y) + (x[j].z * x[j].z + x[j].w * x[j].w); }
        float* xo = xout + (size_t)m * 1024 + 4 * C.lane;
#pragma unroll
        for (int j = 0; j < 4; ++j) st16f(xo + 256 * j, x[j]);
        if (make_xn) {
            const float r2 = rsqrtf(wave_sum(s2) * (1.f / 1024.f) + EPS);
            bf16* o8 = XN + (size_t)m * 1024 + 4 * C.lane;
#pragma unroll
            for (int j = 0; j < 4; ++j) { u32x2 w; w.x = cvt_pk_bf16(x[j].x * r2, x[j].y * r2); w.y = cvt_pk_bf16(x[j].z * r2, x[j].w * r2); st8(o8 + 256 * j, w); }
        }
    }
}

__device__ __forceinline__ void krope_phase(const Ctx& C, const bf16* XN, const bf16* Wr, const float* rcos, const float* rsin, bf16* KR) {
    const int gw = C.vcu * NWAVES + C.wave, NGW = C.G * NWAVES;
    const int fr = C.lane & 15, fq = C.lane >> 4;
    for (int task = gw; task < MTOK / 16; task += NGW) {
        const int m0 = task * 16;
        f32x4 acc0 = {0.f, 0.f, 0.f, 0.f}, acc1 = {0.f, 0.f, 0.f, 0.f};
        const bf16* ap = XN + (size_t)(m0 + fr) * 1024 + 8 * fq;
        const bf16* b0 = Wr + (size_t)fr * 1024 + 8 * fq; const bf16* b1 = Wr + (size_t)(16 + fr) * 1024 + 8 * fq;
#pragma unroll 4
        for (int ks = 0; ks < 32; ++ks) {
            const bf16x8 af = *(const bf16x8*)(ap + ks * 32), bf0 = *(const bf16x8*)(b0 + ks * 32), bf1 = *(const bf16x8*)(b1 + ks * 32);
            acc0 = __builtin_amdgcn_mfma_f32_16x16x32_bf16(af, bf0, acc0, 0, 0, 0);
            acc1 = __builtin_amdgcn_mfma_f32_16x16x32_bf16(af, bf1, acc1, 0, 0, 0);
        }
#pragma unroll
        for (int i = 0; i < 4; ++i) {
            const int row = m0 + 4 * fq + i, pos = row & 2047;
            const float cs = rcos[pos * 16 + fr], sn = rsin[pos * 16 + fr];
            const float x1 = acc0[i], x2 = acc1[i];
            KR[(size_t)row * 32 + fr] = f2bf(x1 * cs - x2 * sn);
            KR[(size_t)row * 32 + 16 + fr] = f2bf(x2 * cs + x1 * sn);
        }
    }
}

__device__ __forceinline__ bf16x8 pack_p(const f32x16& p, int s) {
    u32x4 w; w.x = cvt_pk_bf16(p[8 * s + 0], p[8 * s + 1]); w.y = cvt_pk_bf16(p[8 * s + 2], p[8 * s + 3]); w.z = cvt_pk_bf16(p[8 * s + 4], p[8 * s + 5]); w.w = cvt_pk_bf16(p[8 * s + 6], p[8 * s + 7]);
    return __builtin_bit_cast(bf16x8, w);
}
__device__ __forceinline__ bf16x8 ld_vt(const LAS bf16* p) {
    const u32x2 a = *(const LAS u32x2*)p, b = *(const LAS u32x2*)(p + 8);
    u32x4 w; w.x = a.x; w.y = a.y; w.z = b.x; w.w = b.y; return __builtin_bit_cast(bf16x8, w);
}
#define MFMA32(A, B, C) __builtin_amdgcn_mfma_f32_32x32x16_bf16((A), (B), (C), 0, 0, 0)

constexpr int SW_KP = 72, SW_VP = 264;
__device__ __forceinline__ void swa_phase(const Ctx& C, const bf16* Q, const bf16* KV, const bf16* Z, const float* btab, const float* sinks, bf16* GT) {
    LAS bf16* Kl = (LAS bf16*)C.lds;
    LAS bf16* Vt = Kl + 256 * SW_KP;
    LAS float* Bl = (LAS float*)(Vt + 64 * SW_VP);
    for (int i = C.tid; i < 16 * 200; i += NTHREADS) { const int h = i / 200, d = i % 200 - 36; Bl[i] = (d >= 0 && d < 128) ? btab[h * 128 + d] : -1e30f; }
    const int r = C.lane & 31, hi = C.lane >> 5;
    for (int su = C.vcu; su < 256; su += C.G) {
        const int blk = su & 15, kvh = (su >> 4) & 1, b = su >> 5;
        const int qs = blk * 128, hq = kvh * 8 + C.wave;
        bf16x8 qn[4]; u32x2 zn[8];
        { const bf16* qp = Q + (size_t)(b * 2048 + qs + r) * 1024 + hq * 64 + 8 * hi; const size_t ob0 = (size_t)(b * 2048 + qs + r) * 1024 + hq * 64 + 4 * hi;
#pragma unroll
          for (int s = 0; s < 4; ++s) qn[s] = *(const bf16x8*)(qp + 16 * s);
#pragma unroll
          for (int i4 = 0; i4 < 4; ++i4) { zn[i4] = *(const u32x2*)(Z + ob0 + 8 * i4); zn[4 + i4] = *(const u32x2*)(Z + ob0 + 32 + 8 * i4); } }
        __syncthreads();
        {
            u32x4 kk[4], vv[4];
#pragma unroll
            for (int i = 0; i < 4; ++i) {
                const int idx = C.tid + i * NTHREADS, key = idx >> 3, ch = idx & 7, pos = qs - 128 + key;
                kk[i] = (u32x4){0u, 0u, 0u, 0u}; vv[i] = kk[i];
                if (pos >= 0) { const bf16* src = KV + (size_t)(b * 2048 + pos) * 256 + kvh * 64 + ch * 8; kk[i] = ld16(src); vv[i] = ld16(src + 128); }
            }
#pragma unroll
            for (int i = 0; i < 4; ++i) {
                const int idx = C.tid + i * NTHREADS, key = idx >> 3, ch = idx & 7;
                *(LAS u32x4*)(Kl + key * SW_KP + ch * 8) = kk[i];
                LAS bf16* vd = Vt + (ch * 8) * SW_VP + key;
                vd[0 * SW_VP] = (bf16)(vv[i].x & 0xffff); vd[1 * SW_VP] = (bf16)(vv[i].x >> 16); vd[2 * SW_VP] = (bf16)(vv[i].y & 0xffff); vd[3 * SW_VP] = (bf16)(vv[i].y >> 16);
                vd[4 * SW_VP] = (bf16)(vv[i].z & 0xffff); vd[5 * SW_VP] = (bf16)(vv[i].z >> 16); vd[6 * SW_VP] = (bf16)(vv[i].w & 0xffff); vd[7 * SW_VP] = (bf16)(vv[i].w >> 16);
            }
        }
        __syncthreads();
        const float sink2 = sinks[hq] * LOG2E;
        for (int sj = 0; sj < 4; ++sj) {
            const int q0 = qs + 32 * sj;
            const LAS bf16* Ks = Kl + (32 * sj) * SW_KP; const LAS bf16* Vs = Vt + 32 * sj;
            const size_t ob = (size_t)(b * 2048 + q0 + r) * 1024 + hq * 64 + 4 * hi;
            bf16x8 qf[4]; u32x2 zg[8];
#pragma unroll
            for (int s = 0; s < 4; ++s) qf[s] = qn[s];
#pragma unroll
            for (int i = 0; i < 8; ++i) zg[i] = zn[i];
            if (sj + 1 < 4) { const bf16* qp = Q + (size_t)(b * 2048 + q0 + 32 + r) * 1024 + hq * 64 + 8 * hi;
#pragma unroll
                for (int s = 0; s < 4; ++s) qn[s] = *(const bf16x8*)(qp + 16 * s);
#pragma unroll
                for (int i4 = 0; i4 < 4; ++i4) { zn[i4] = *(const u32x2*)(Z + ob + 32 * 1024 + 8 * i4); zn[4 + i4] = *(const u32x2*)(Z + ob + 32 * 1024 + 32 + 8 * i4); } }
            f32x16 st[5];
#pragma unroll
            for (int t = 0; t < 5; ++t) {
                f32x16 acc = {0.f,0.f,0.f,0.f,0.f,0.f,0.f,0.f,0.f,0.f,0.f,0.f,0.f,0.f,0.f,0.f};
#pragma unroll
                for (int s = 0; s < 4; ++s) { const bf16x8 kf = *(const LAS bf16x8*)(Ks + (32 * t + r) * SW_KP + 16 * s + 8 * hi); acc = MFMA32(kf, qf[s], acc); }
                st[t] = acc;
            }
            float mx = sink2;
            const LAS float* bl = Bl + hq * 200 + (5 + r - 4 * hi);
#pragma unroll
            for (int t = 0; t < 5; ++t)
#pragma unroll
                for (int i = 0; i < 16; ++i) {
                    float sc = st[t][i] + bl[159 - (32 * t + (i & 3) + 8 * (i >> 2))];
                    if (q0 < 128) { if (q0 - 128 + 32 * t + crow(i, hi) < 0) sc = -1e30f; }
                    st[t][i] = sc; mx = fmaxf(mx, sc);
                }
            mx = fmaxf(mx, __shfl_xor(mx, 32));
            float l = 0.f;
#pragma unroll
            for (int t = 0; t < 5; ++t)
#pragma unroll
                for (int i = 0; i < 16; ++i) { const float p = fast_exp2(st[t][i] - mx); st[t][i] = p; l += p; }
            l += __shfl_xor(l, 32);
            l += fast_exp2(sink2 - mx);
            f32x16 o0 = {0.f,0.f,0.f,0.f,0.f,0.f,0.f,0.f,0.f,0.f,0.f,0.f,0.f,0.f,0.f,0.f}, o1 = o0;
#pragma unroll
            for (int t = 0; t < 5; ++t)
#pragma unroll
                for (int s = 0; s < 2; ++s) {
                    const bf16x8 pf = pack_p(st[t], s);
                    const bf16x8 v0 = ld_vt(Vs + r * SW_VP + 32 * t + 16 * s + 4 * hi), v1 = ld_vt(Vs + (32 + r) * SW_VP + 32 * t + 16 * s + 4 * hi);
                    o0 = MFMA32(v0, pf, o0); o1 = MFMA32(v1, pf, o1);
                }
            const float inv = fast_rcp(l);
#pragma unroll
            for (int i4 = 0; i4 < 4; ++i4) {
                const u32x2 z0 = zg[i4], z1 = zg[4 + i4];
                u32x2 w0, w1;
                w0.x = cvt_pk_bf16(o0[4 * i4 + 0] * inv * bf_lo(z0.x), o0[4 * i4 + 1] * inv * bf_hi(z0.x)); w0.y = cvt_pk_bf16(o0[4 * i4 + 2] * inv * bf_lo(z0.y), o0[4 * i4 + 3] * inv * bf_hi(z0.y));
                w1.x = cvt_pk_bf16(o1[4 * i4 + 0] * inv * bf_lo(z1.x), o1[4 * i4 + 1] * inv * bf_hi(z1.x)); w1.y = cvt_pk_bf16(o1[4 * i4 + 2] * inv * bf_lo(z1.y), o1[4 * i4 + 3] * inv * bf_hi(z1.y));
                st8(GT + ob + 8 * i4, w0); st8(GT + ob + 32 + 8 * i4, w1);
            }
        }
    }
    __syncthreads();
}

constexpr int ML_KP = 104, ML_VP = 72;
__device__ __forceinline__ void mla_phase(const Ctx& C, const bf16* Q, const bf16* KN, const bf16* KR, const bf16* V, const bf16* Z, const float* ssq, const float* rcos, const float* rsin, bf16* GT) {
    LAS bf16* Kb = (LAS bf16*)C.lds;
    LAS bf16* Vb = Kb + 2 * 64 * ML_KP;
    const int r = C.lane & 31, hi = C.lane >> 5;
    const int skey = C.tid >> 3, sch = C.tid & 7;
    const int rkey = (C.tid >> 2) & 63, rch = C.tid & 3;
    for (int ui = 0; ui < 4; ++ui) {
        for (int base = C.vcu; base < 256; base += C.G) {
        const int bh = base >> 1, b = bh >> 4, hh = bh & 15;
        int qb;
        if ((base & 1) == 0) qb = (ui == 0) ? 7 : (ui == 1) ? 0 : (ui == 2) ? 6 : 1; else qb = (ui == 0) ? 5 : (ui == 1) ? 2 : (ui == 2) ? 4 : 3;
        const int q0w = qb * 256 + C.wave * 32;
        const int ntiles = 4 * (qb + 1);
        bf16x8 qf[6];
        { const int qrow = b * 2048 + q0w + r;
          const bf16* qp = Q + (size_t)qrow * 1536 + hh * 96 + 8 * hi;
          u32x4 qraw[6];
#pragma unroll
          for (int s = 0; s < 6; ++s) qraw[s] = ld16(qp + 16 * s);
          float ss = 0.f;
#pragma unroll
          for (int t = 0; t < 12; ++t) ss += ssq[(size_t)(hi * 12 + t) * MTOK + qrow];
          ss += __shfl_xor(ss, 32);
          const float qs = rsqrtf(ss * (1.f / 768.f) + EPS) * QS_MLA;
          const float* cp = rcos + (q0w + r) * 16 + 8 * hi; const float* sp = rsin + (q0w + r) * 16 + 8 * hi;
          const f32x4 c0 = *(const f32x4*)cp, c1 = *(const f32x4*)(cp + 4), s0v = *(const f32x4*)sp, s1v = *(const f32x4*)(sp + 4);
          float f4[8], f5[8]; unpack8(qraw[4], f4); unpack8(qraw[5], f5);
#pragma unroll
          for (int j = 0; j < 8; ++j) { const float cc = j < 4 ? c0[j] : c1[j - 4], sn = j < 4 ? s0v[j] : s1v[j - 4]; const float x1 = f4[j], x2 = f5[j]; f4[j] = (x1 * cc - x2 * sn) * qs; f5[j] = (x2 * cc + x1 * sn) * qs; }
#pragma unroll
          for (int s = 0; s < 4; ++s) { float f[8]; unpack8(qraw[s], f);
#pragma unroll
              for (int j = 0; j < 8; ++j) f[j] *= qs;
              qf[s] = __builtin_bit_cast(bf16x8, pack8(f)); }
          qf[4] = __builtin_bit_cast(bf16x8, pack8(f4)); qf[5] = __builtin_bit_cast(bf16x8, pack8(f5)); }
        float mrun = -1e30f, lrun = 0.f;
        f32x16 o0 = {0.f,0.f,0.f,0.f,0.f,0.f,0.f,0.f,0.f,0.f,0.f,0.f,0.f,0.f,0.f,0.f}, o1 = o0;
        const bf16* knp = KN + (size_t)(b * 2048 + skey) * 1024 + hh * 64 + sch * 8;
        const bf16* vp  = V  + (size_t)(b * 2048 + skey) * 1024 + hh * 64 + sch * 8;
        const bf16* krp = KR + (size_t)(b * 2048 + rkey) * 32 + rch * 8;
        u32x4 gk = ld16(knp), gv = ld16(vp), gr = {0u, 0u, 0u, 0u};
        if (C.tid < 256) gr = ld16(krp);
        for (int t = 0; t < ntiles; ++t) {
            const int bb = t & 1;
            LAS bf16* Kl = Kb + bb * 64 * ML_KP; LAS bf16* Vl = Vb + bb * 64 * ML_VP;
            *(LAS u32x4*)(Kl + skey * ML_KP + sch * 8) = gk;
            if (C.tid < 256) *(LAS u32x4*)(Kl + rkey * ML_KP + 64 + rch * 8) = gr;
            { LAS bf16* vd = Vl + (sch * 8) * ML_VP + skey;
              vd[0 * ML_VP] = (bf16)(gv.x & 0xffff); vd[1 * ML_VP] = (bf16)(gv.x >> 16); vd[2 * ML_VP] = (bf16)(gv.y & 0xffff); vd[3 * ML_VP] = (bf16)(gv.y >> 16);
              vd[4 * ML_VP] = (bf16)(gv.z & 0xffff); vd[5 * ML_VP] = (bf16)(gv.z >> 16); vd[6 * ML_VP] = (bf16)(gv.w & 0xffff); vd[7 * ML_VP] = (bf16)(gv.w >> 16); }
            __syncthreads();
            if (t + 1 < ntiles) { const size_t adv = (size_t)(t + 1) * 64; gk = ld16(knp + adv * 1024); gv = ld16(vp + adv * 1024); if (C.tid < 256) gr = ld16(krp + adv * 32); }
            const int k0 = t * 64;
            if (k0 <= q0w + 31) {
                f32x16 s0 = {0.f,0.f,0.f,0.f,0.f,0.f,0.f,0.f,0.f,0.f,0.f,0.f,0.f,0.f,0.f,0.f}, s1 = s0;
#pragma unroll
                for (int s = 0; s < 6; ++s) {
                    const bf16x8 k0f = *(const LAS bf16x8*)(Kl + r * ML_KP + 16 * s + 8 * hi), k1f = *(const LAS bf16x8*)(Kl + (32 + r) * ML_KP + 16 * s + 8 * hi);
                    s0 = MFMA32(k0f, qf[s], s0); s1 = MFMA32(k1f, qf[s], s1);
                }
                if (k0 + 63 > q0w) {
                    const int qpos = q0w + r;
#pragma unroll
                    for (int i = 0; i < 16; ++i) { const int kp = k0 + crow(i, hi); if (kp > qpos) s0[i] = -1e30f; if (kp + 32 > qpos) s1[i] = -1e30f; }
                }
                float tm = s0[0];
#pragma unroll
                for (int i = 1; i < 16; ++i) tm = fmaxf(tm, s0[i]);
#pragma unroll
                for (int i = 0; i < 16; ++i) tm = fmaxf(tm, s1[i]);
                tm = fmaxf(tm, __shfl_xor(tm, 32));
                const float mn = fmaxf(mrun, tm), alpha = fast_exp2(mrun - mn);
                mrun = mn;
                float ps = 0.f;
#pragma unroll
                for (int i = 0; i < 16; ++i) { s0[i] = fast_exp2(s0[i] - mn); s1[i] = fast_exp2(s1[i] - mn); ps += s0[i] + s1[i]; }
                lrun = lrun * alpha + ps;
#pragma unroll
                for (int i = 0; i < 16; ++i) { o0[i] *= alpha; o1[i] *= alpha; }
#pragma unroll
                for (int s = 0; s < 2; ++s) {
                    const bf16x8 p0 = pack_p(s0, s), p1 = pack_p(s1, s);
                    const bf16x8 va0 = ld_vt(Vl + r * ML_VP + 16 * s + 4 * hi), va1 = ld_vt(Vl + (32 + r) * ML_VP + 16 * s + 4 * hi);
                    const bf16x8 vb0 = ld_vt(Vl + r * ML_VP + 32 + 16 * s + 4 * hi), vb1 = ld_vt(Vl + (32 + r) * ML_VP + 32 + 16 * s + 4 * hi);
                    o0 = MFMA32(va0, p0, o0); o1 = MFMA32(va1, p0, o1);
                    o0 = MFMA32(vb0, p1, o0); o1 = MFMA32(vb1, p1, o1);
                }
            }
        }
        const float lt = lrun + __shfl_xor(lrun, 32);
        const float inv = fast_rcp(lt);
        const size_t ob = (size_t)(b * 2048 + q0w + r) * 1024 + hh * 64 + 4 * hi;
#pragma unroll
        for (int i4 = 0; i4 < 4; ++i4) {
            const u32x2 z0 = *(const u32x2*)(Z + ob + 8 * i4), z1 = *(const u32x2*)(Z + ob + 32 + 8 * i4);
            u32x2 w0, w1;
            w0.x = cvt_pk_bf16(o0[4 * i4 + 0] * inv * bf_lo(z0.x), o0[4 * i4 + 1] * inv * bf_hi(z0.x)); w0.y = cvt_pk_bf16(o0[4 * i4 + 2] * inv * bf_lo(z0.y), o0[4 * i4 + 3] * inv * bf_hi(z0.y));
            w1.x = cvt_pk_bf16(o1[4 * i4 + 0] * inv * bf_lo(z1.x), o1[4 * i4 + 1] * inv * bf_hi(z1.x)); w1.y = cvt_pk_bf16(o1[4 * i4 + 2] * inv * bf_lo(z1.y), o1[4 * i4 + 3] * inv * bf_hi(z1.y));
            st8(GT + ob + 8 * i4, w0); st8(GT + ob + 32 + 8 * i4, w1);
        }
        }
    }
    __syncthreads();
}

constexpr int SG_WP = 136, SG_NP = 136;
__device__ __forceinline__ void sgu_phase(const Ctx& C, const bf16* U, const bf16* Vv, const bf16* Z, const float* ssum, const float* ssq, const float* lng, const float* lnb,
                                          const bf16* wsb, const float* bs_, bf16* GT) {
    LAS bf16* Wl = (LAS bf16*)C.lds;
    LAS bf16* Vn = Wl + 128 * SG_WP;
    LAS float* St = (LAS float*)(Vn + 64 * SG_NP);
    LAS float* Pp = St + 256;
    const int r = C.lane & 31, hi = C.lane >> 5;
    const int ct = C.wave & 1, tt = C.wave >> 1;
    for (int item = C.vcu; item < 256; item += C.G) {
        const int bn = item >> 1, gh = item & 1, b = bn >> 4, n = bn & 15;
        const int tok0 = b * 2048 + n * 128;
        __syncthreads();
        { const int tk = C.tid & 127, part = C.tid >> 7; float a = 0.f, q = 0.f;
#pragma unroll
          for (int s = 0; s < 8; ++s) { a += ssum[(size_t)(part * 8 + s) * MTOK + tok0 + tk]; q += ssq[(size_t)(part * 8 + s) * MTOK + tok0 + tk]; }
          Pp[(part * 128 + tk) * 2] = a; Pp[(part * 128 + tk) * 2 + 1] = q; }
        __syncthreads();
        if (C.tid < 128) {
            const float a = Pp[C.tid * 2] + Pp[(128 + C.tid) * 2] + Pp[(256 + C.tid) * 2] + Pp[(384 + C.tid) * 2];
            const float q = Pp[C.tid * 2 + 1] + Pp[(128 + C.tid) * 2 + 1] + Pp[(256 + C.tid) * 2 + 1] + Pp[(384 + C.tid) * 2 + 1];
            const float mu = a * (1.f / 1024.f), var = q * (1.f / 1024.f) - mu * mu;
            St[C.tid * 2] = mu; St[C.tid * 2 + 1] = rsqrtf(fmaxf(var, 0.f) + EPS);
        }
        const int t = 32 * tt + r;
        u32x4 wr_[4], vr_[2]; u32x2 ugn[4], zgn[4]; float bsn;
#define SGU_PREFETCH(G_) do { const int g_ = (G_); \
          _Pragma("unroll") for (int i = 0; i < 4; ++i) wr_[i] = ld16(wsb + (size_t)g_ * 16384 + (size_t)(C.tid + i * NTHREADS) * 8); \
          _Pragma("unroll") for (int i = 0; i < 2; ++i) { const int idx = C.tid + i * NTHREADS, s_ = idx >> 3, ch = idx & 7; vr_[i] = ld16(Vv + (size_t)(tok0 + s_) * 1024 + g_ * 64 + ch * 8); } \
          const size_t ob_ = (size_t)(tok0 + t) * 1024 + g_ * 64 + 32 * ct + 4 * hi; \
          _Pragma("unroll") for (int i4 = 0; i4 < 4; ++i4) { ugn[i4] = *(const u32x2*)(U + ob_ + 8 * i4); zgn[i4] = *(const u32x2*)(Z + ob_ + 8 * i4); } \
          bsn = bs_[g_ * 128 + t]; } while (0)
        SGU_PREFETCH(gh * 8);
        for (int gi = 0; gi < 8; ++gi) {
            const int g = gh * 8 + gi;
            __syncthreads();
#pragma unroll
            for (int i = 0; i < 4; ++i) { const int idx = C.tid + i * NTHREADS, tw = idx >> 4, c16 = idx & 15; *(LAS u32x4*)(Wl + tw * SG_WP + c16 * 8) = wr_[i]; }
#pragma unroll
            for (int i = 0; i < 2; ++i) {
                const int idx = C.tid + i * NTHREADS, s = idx >> 3, ch = idx & 7;
                float v[8]; unpack8(vr_[i], v);
                const float mu = St[s * 2], rs = St[s * 2 + 1];
                const f32x4 g0v = *(const f32x4*)(lng + g * 64 + ch * 8), g1v = *(const f32x4*)(lng + g * 64 + ch * 8 + 4);
                const f32x4 b0v = *(const f32x4*)(lnb + g * 64 + ch * 8), b1v = *(const f32x4*)(lnb + g * 64 + ch * 8 + 4);
                LAS bf16* vd = Vn + (ch * 8) * SG_NP + s;
#pragma unroll
                for (int j = 0; j < 8; ++j) { const float gg = j < 4 ? g0v[j] : g1v[j - 4], bb = j < 4 ? b0v[j] : b1v[j - 4]; vd[j * SG_NP] = f2bf((v[j] - mu) * rs * gg + bb); }
            }
            u32x2 ug[4], zg[4];
#pragma unroll
            for (int i4 = 0; i4 < 4; ++i4) { ug[i4] = ugn[i4]; zg[i4] = zgn[i4]; }
            const float bsv = bsn;
            __syncthreads();
            if (gi + 1 < 8) SGU_PREFETCH(g + 1);
            const size_t ob = (size_t)(tok0 + t) * 1024 + g * 64 + 32 * ct + 4 * hi;
            f32x16 acc = {0.f,0.f,0.f,0.f,0.f,0.f,0.f,0.f,0.f,0.f,0.f,0.f,0.f,0.f,0.f,0.f};
            const int nks = 2 * (tt + 1);
            for (int ks = 0; ks < nks; ++ks) {
                const bf16x8 af = *(const LAS bf16x8*)(Vn + (32 * ct + r) * SG_NP + 16 * ks + 8 * hi);
                const bf16x8 bf = *(const LAS bf16x8*)(Wl + (32 * tt + r) * SG_WP + 16 * ks + 8 * hi);
                acc = MFMA32(af, bf, acc);
            }
#pragma unroll
            for (int i4 = 0; i4 < 4; ++i4) {
                const u32x2 uu = ug[i4], zz = zg[i4];
                u32x2 w;
                w.x = cvt_pk_bf16(bf_lo(uu.x) * (acc[4 * i4 + 0] + bsv) * bf_lo(zz.x), bf_hi(uu.x) * (acc[4 * i4 + 1] + bsv) * bf_hi(zz.x));
                w.y = cvt_pk_bf16(bf_lo(uu.y) * (acc[4 * i4 + 2] + bsv) * bf_lo(zz.y), bf_hi(uu.y) * (acc[4 * i4 + 3] + bsv) * bf_hi(zz.y));
                st8(GT + ob + 8 * i4, w);
            }
        }
#undef SGU_PREFETCH
    }
    __syncthreads();
}

constexpr int NPHASE = 20;
#define AS4 __attribute__((address_space(4)))
#define PH_BEGIN const AS4 Args* ap = (const AS4 Args*)__builtin_amdgcn_kernarg_segment_ptr(); asm volatile("" : "+s"(ap)); unsigned char* const ws = ap->ws; (void)ws
#define P_XN ((bf16*)(ws + WS_XN))
#define P_ZB ((bf16*)(ws + WS_Z))
#define P_GT ((bf16*)(ws + WS_GT))
#define P_YB ((bf16*)(ws + WS_Y))
#define P_S1 ((float*)(ws + TAB_S1))
#define P_S2 ((float*)(ws + TAB_S2))
#define P_RCOS ((const float*)(ws + TAB_ROPE))
#define P_RSIN ((const float*)(ws + TAB_ROPE) + 2048 * 16)
#ifndef PH_MASK
#define PH_MASK 0xFFFFFFu
#endif
#ifndef REP_MASK
#define REP_MASK 0u
#endif
#define RUNS(k) ((((REP_MASK) >> (k)) & 1u) ? 2 : 1)
__global__ void __launch_bounds__(NTHREADS, 2) hybrid_fwd(Args args) {
    extern __shared__ __attribute__((aligned(16))) unsigned char lds_raw[];
    Ctx C;
    C.lds = (LAS unsigned char*)lds_raw;
    C.tid = threadIdx.x; C.lane = C.tid & 63; C.wave = __builtin_amdgcn_readfirstlane(C.tid >> 6);
    C.G = gridDim.x; { const int bx = blockIdx.x; C.vcu = (C.G % 8 == 0) ? (bx % 8) * (C.G / 8) + bx / 8 : bx; }
    volatile LAS unsigned* MISC = (volatile LAS unsigned*)(C.lds + LDSCTL_OFF);
    for (int u = C.tid; u < (LDS_BYTES - LDSCTL_OFF) / 4; u += NTHREADS) ((LAS unsigned*)(C.lds + LDSCTL_OFF))[u] = 0u;
    __syncthreads();
    const int lo = args.ph_lo, hi = args.ph_hi;
    if (hi - lo > 1) (void)xcd_barrier_post((unsigned*)(args.ws + WS_CTL) + CW_BAR, MISC + 8);
#define IN(k) (((PH_MASK >> (k)) & 1u) && lo <= (k) && (k) < hi)
#define SEAM(k) do { if (IN(k) && IN((k) + 1)) { XcdBarrier b_; b_.bar = (unsigned*)(((const AS4 Args*)__builtin_amdgcn_kernarg_segment_ptr())->ws + WS_CTL) + CW_BAR; b_.x = xb_xcc_id(); \
        b_.st = (volatile LAS unsigned*)(C.lds + LDSCTL_OFF) + 8; xcd_barrier(b_); } } while (0)
    LAS unsigned char* ring = C.lds;
    const int bx = (int)blockIdx.x;

    if (IN(0)) for (int rep_ = 0; rep_ < RUNS(0); ++rep_) { { PH_BEGIN; prologue(ap, C); } { PH_BEGIN; prologue_tables(ap, C); } { PH_BEGIN; prologue_s5(ap, C); } } SEAM(0);

    if (IN(1)) for (int rep_ = 0; rep_ < RUNS(1); ++rep_) { PH_BEGIN; pg8::Gemm g{P_XN, (const bf16*)(ws + W_A_IN), 1024, 1024, 1024}; pg8::StaticOrder S; S.init(MTOK, 2048, C.G, bx);
        Epi8<OpAin> E{{(bf16*)(ws + S5_A2), P_ZB}}; pg8::gemm_phase<Epi8<OpAin>, pg8::StaticOrder, true>(ring, g, S, E); } SEAM(1);
    if (IN(2)) for (int rep_ = 0; rep_ < RUNS(2); ++rep_) { PH_BEGIN; pg8::Gemm g{(const bf16*)(ws + S5_A2), (const bf16*)(ws + S5_BST), 512, 640, 512}; OrderS5a S{C.vcu, C.G};
        EpiAscan E{(const float*)(ws + TAB_A32), (bf16*)(ws + S5_A2)}; pg8::gemm_phase<EpiAscan, OrderS5a, false>(ring, g, S, E); } SEAM(2);
    if (IN(3)) for (int rep_ = 0; rep_ < RUNS(3); ++rep_) { PH_BEGIN; pg8::Gemm g{(const bf16*)(ws + S5_A2), (const bf16*)(ws + S5_B2), 640, 640, 640}; OrderS5b S{C.vcu, C.G};
        Epi8<OpAy> E{{(const bf16*)(ws + S5_A2), ap->in[12], P_YB}}; pg8::gemm_phase<Epi8<OpAy>, OrderS5b, false>(ring, g, S, E); } SEAM(3);
    if (IN(4)) for (int rep_ = 0; rep_ < RUNS(4); ++rep_) { PH_BEGIN; pg8::Gemm g{P_YB, (const bf16*)(ws + W_A_GLU), 1024, 1024, 1024}; pg8::StaticOrder S; S.init(MTOK, 1024, C.G, bx);
        Epi8<OpAglu> E{{P_YB, P_ZB, ap->in[14], P_GT}}; pg8::gemm_phase<Epi8<OpAglu>, pg8::StaticOrder, false>(ring, g, S, E); } SEAM(4);
    if (IN(5)) for (int rep_ = 0; rep_ < RUNS(5); ++rep_) { PH_BEGIN; pg8::Gemm g{P_GT, (const bf16*)(ws + W_A_OUT), 1024, 1024, 1024}; pg8::StaticOrder S; S.init(MTOK, 1024, C.G, bx);
        Epi8<OpOut> E{{P_YB}}; pg8::gemm_phase<Epi8<OpOut>, pg8::StaticOrder, false>(ring, g, S, E); } SEAM(5);
    if (IN(6)) for (int rep_ = 0; rep_ < RUNS(6); ++rep_) { PH_BEGIN; row_phase(C, P_YB, ap->in[0], ap->out, ap->in[2], P_XN, true); } SEAM(6);

    if (IN(7)) for (int rep_ = 0; rep_ < RUNS(7); ++rep_) { PH_BEGIN; pg8::Gemm g{P_XN, (const bf16*)(ws + W_B_IN), 1024, 1024, 1024}; pg8::StaticOrder S; S.init(MTOK, 2304, C.G, bx);
        Epi8<OpBin> E{{(bf16*)(ws + SW_Q), (bf16*)(ws + SW_KV), P_ZB}}; pg8::gemm_phase<Epi8<OpBin>, pg8::StaticOrder, true>(ring, g, S, E); } SEAM(7);
    if (IN(8)) for (int rep_ = 0; rep_ < RUNS(8); ++rep_) { PH_BEGIN; swa_phase(C, (const bf16*)(ws + SW_Q), (const bf16*)(ws + SW_KV), P_ZB, (const float*)(ws + TAB_BIAS), ap->in[17], P_GT); } SEAM(8);
    if (IN(9)) for (int rep_ = 0; rep_ < RUNS(9); ++rep_) { PH_BEGIN; pg8::Gemm g{P_GT, (const bf16*)(ws + W_B_OUT), 1024, 1024, 1024}; pg8::StaticOrder S; S.init(MTOK, 1024, C.G, bx);
        Epi8<OpOut> E{{P_YB}}; pg8::gemm_phase<Epi8<OpOut>, pg8::StaticOrder, false>(ring, g, S, E); } SEAM(9);
    if (IN(10)) for (int rep_ = 0; rep_ < RUNS(10); ++rep_) { PH_BEGIN; row_phase(C, P_YB, ap->out, ap->out, ap->in[2] + 1024, P_XN, true); } SEAM(10);

    if (IN(11)) for (int rep_ = 0; rep_ < RUNS(11); ++rep_) { PH_BEGIN; pg8::Gemm g{P_XN, (const bf16*)(ws + W_C_IN), 1024, 1024, 1024}; pg8::StaticOrder S; S.init(MTOK, 2048, C.G, bx);
        Epi8<OpCin> E{{(bf16*)(ws + ML_CQ), (bf16*)(ws + ML_CKV), P_ZB, P_S1}}; pg8::gemm_phase<Epi8<OpCin>, pg8::StaticOrder, true>(ring, g, S, E);
        krope_phase(C, P_XN, (const bf16*)(ws + W_C_ROPE), P_RCOS, P_RSIN, (bf16*)(ws + ML_KR)); } SEAM(11);
    if (IN(12)) for (int rep_ = 0; rep_ < RUNS(12); ++rep_) { PH_BEGIN;
        { pg8::Gemm g{(const bf16*)(ws + ML_CQ), (const bf16*)(ws + W_C_UQ), 768, 768, 768}; pg8::StaticOrder S; S.init(MTOK, 1536, C.G, bx);
          Epi8<OpQ> E{{(bf16*)(ws + ML_Q)}}; pg8::gemm_phase<Epi8<OpQ>, pg8::StaticOrder, true>(ring, g, S, E); }
        { pg8::Gemm g{(const bf16*)(ws + ML_CKV), (const bf16*)(ws + W_C_UKV), 256, 256, 256}; pg8::StaticOrder S; S.init(MTOK, 2048, C.G, C.G - 1 - bx);
          EpiCukv E{P_S1, (bf16*)(ws + ML_KN), (bf16*)(ws + ML_V)}; pg8::gemm_phase<EpiCukv, pg8::StaticOrder, true>(ring, g, S, E); }
    } SEAM(12);
    if (IN(13)) for (int rep_ = 0; rep_ < RUNS(13); ++rep_) { PH_BEGIN; mla_phase(C, (const bf16*)(ws + ML_Q), (const bf16*)(ws + ML_KN), (const bf16*)(ws + ML_KR), (const bf16*)(ws + ML_V), P_ZB, P_S1, P_RCOS, P_RSIN, P_GT); } SEAM(13);
    if (IN(14)) for (int rep_ = 0; rep_ < RUNS(14); ++rep_) { PH_BEGIN; pg8::Gemm g{P_GT, (const bf16*)(ws + W_C_OUT), 1024, 1024, 1024}; pg8::StaticOrder S; S.init(MTOK, 1024, C.G, bx);
        Epi8<OpOut> E{{P_YB}}; pg8::gemm_phase<Epi8<OpOut>, pg8::StaticOrder, false>(ring, g, S, E); } SEAM(14);
    if (IN(15)) for (int rep_ = 0; rep_ < RUNS(15); ++rep_) { PH_BEGIN; row_phase(C, P_YB, ap->out, ap->out, ap->in[2] + 2048, P_XN, true); } SEAM(15);

    if (IN(16)) for (int rep_ = 0; rep_ < RUNS(16); ++rep_) { PH_BEGIN; pg8::Gemm g{P_XN, (const bf16*)(ws + W_D_IN), 1024, 1024, 1024}; pg8::StaticOrder S; S.init(MTOK, 3072, C.G, bx);
        Epi8<OpDin> E{{(bf16*)(ws + SG_U), (bf16*)(ws + SG_V), P_ZB, P_S1, P_S2}}; pg8::gemm_phase<Epi8<OpDin>, pg8::StaticOrder, true>(ring, g, S, E); } SEAM(16);
    if (IN(17)) for (int rep_ = 0; rep_ < RUNS(17); ++rep_) { PH_BEGIN; sgu_phase(C, (const bf16*)(ws + SG_U), (const bf16*)(ws + SG_V), P_ZB, P_S1, P_S2, ap->in[26], ap->in[27], (const bf16*)(ws + TAB_WS), ap->in[29], P_GT); } SEAM(17);
    if (IN(18)) for (int rep_ = 0; rep_ < RUNS(18); ++rep_) { PH_BEGIN; pg8::Gemm g{P_GT, (const bf16*)(ws + W_D_OUT), 1024, 1024, 1024}; pg8::StaticOrder S; S.init(MTOK, 1024, C.G, bx);
        Epi8<OpOut> E{{P_YB}}; pg8::gemm_phase<Epi8<OpOut>, pg8::StaticOrder, false>(ring, g, S, E); } SEAM(18);
    if (IN(19)) for (int rep_ = 0; rep_ < RUNS(19); ++rep_) { PH_BEGIN; row_phase(C, P_YB, ap->out, ap->out, ap->in[2] + 3072, P_XN, false); }
#undef IN
#undef SEAM
}

extern "C" void kernel_launch(void* const* d_in, const int* in_sizes, int n_in, void* d_out, int out_size, void* d_ws, size_t ws_size, hipStream_t stream) {
    static int grid = 0;
    if (grid == 0) {
        if (n_in != 31 || out_size != MTOK * DM || ws_size < WS_END) { fprintf(stderr, "kernel_launch: unexpected shapes (n_in %d, out %d, ws %zu)\n", n_in, out_size, ws_size); grid = -1; return; }
        int dev = 0, cus = 0, per_cu = 0;
        if (hipGetDevice(&dev) != hipSuccess || hipDeviceGetAttribute(&cus, hipDeviceAttributeMultiprocessorCount, dev) != hipSuccess) { grid = -1; return; }
        if (hipFuncSetAttribute((const void*)hybrid_fwd, hipFuncAttributeMaxDynamicSharedMemorySize, LDS_BYTES) != hipSuccess) { fprintf(stderr, "kernel_launch: hipFuncSetAttribute failed\n"); grid = -1; return; }
        if (hipOccupancyMaxActiveBlocksPerMultiprocessor(&per_cu, (const void*)hybrid_fwd, NTHREADS, LDS_BYTES) != hipSuccess || per_cu < 1)
            fprintf(stderr, "kernel_launch: occupancy query reports %d workgroups per CU\n", per_cu);
        (void)hipGetLastError();
        grid = cus;
    }
    if (grid < 0) return;
    (void)hipMemsetAsync((char*)d_ws + WS_CTL, 0, CTL_ZERO_BYTES, stream);
    Args a{};
    for (int i = 0; i < 31; ++i) a.in[i] = (const float*)d_in[i];
    a.out = (float*)d_out; a.ws = (unsigned char*)d_ws;
#if MK_ONE_LAUNCH
    a.ph_lo = 0; a.ph_hi = NPHASE;
    hipLaunchKernelGGL(hybrid_fwd, dim3(grid), dim3(NTHREADS), LDS_BYTES, stream, a);
#else
    for (int p = 0; p < NPHASE; ++p) { a.ph_lo = p; a.ph_hi = p + 1; hipLaunchKernelGGL(hybrid_fwd, dim3(grid), dim3(NTHREADS), LDS_BYTES, stream, a); }
#endif
}
```

```cpp
#include <hip/hip_runtime.h>
#include <cstdio>
#include <cstdint>

#define LAS __attribute__((address_space(3)))
#define GAS __attribute__((address_space(1)))
typedef unsigned short bf16;
typedef short bf16x8 __attribute__((ext_vector_type(8)));
typedef short bf16x4 __attribute__((ext_vector_type(4)));
typedef float f32x4 __attribute__((ext_vector_type(4)));
typedef float f32x2 __attribute__((ext_vector_type(2)));
typedef float f32x16 __attribute__((ext_vector_type(16)));
typedef unsigned u32x4 __attribute__((ext_vector_type(4)));
typedef unsigned u32x2 __attribute__((ext_vector_type(2)));

#ifndef MK_ONE_LAUNCH
#define MK_ONE_LAUNCH 1
#endif

constexpr int BATCH = 8, SEQ = 2048, DM = 1024, MTOK = BATCH * SEQ;
constexpr float EPS = 1e-6f;
constexpr float LOG2E = 1.4426950408889634f;
constexpr int NWAVES = 8, NTHREADS = 512;

__device__ __forceinline__ unsigned cvt_pk_bf16(float lo, float hi) { unsigned r; asm volatile("v_cvt_pk_bf16_f32 %0, %1, %2" : "=v"(r) : "v"(lo), "v"(hi)); return r; }
__device__ __forceinline__ float bf_lo(unsigned w) { return __uint_as_float(w << 16); }
__device__ __forceinline__ float bf_hi(unsigned w) { return __uint_as_float(w & 0xffff0000u); }
__device__ __forceinline__ float bf2f(bf16 h) { return __uint_as_float(((unsigned)h) << 16); }
__device__ __forceinline__ bf16 f2bf(float f) { return (bf16)(cvt_pk_bf16(f, 0.f) & 0xffffu); }
__device__ __forceinline__ u32x4 pack8(const float (&v)[8]) { u32x4 w; w.x = cvt_pk_bf16(v[0], v[1]); w.y = cvt_pk_bf16(v[2], v[3]); w.z = cvt_pk_bf16(v[4], v[5]); w.w = cvt_pk_bf16(v[6], v[7]); return w; }
__device__ __forceinline__ void unpack8(u32x4 w, float (&v)[8]) { v[0] = bf_lo(w.x); v[1] = bf_hi(w.x); v[2] = bf_lo(w.y); v[3] = bf_hi(w.y); v[4] = bf_lo(w.z); v[5] = bf_hi(w.z); v[6] = bf_lo(w.w); v[7] = bf_hi(w.w); }
__device__ __forceinline__ float fast_rcp(float x) { return __builtin_amdgcn_rcpf(x); }
__device__ __forceinline__ float fast_exp2(float x) { return __builtin_amdgcn_exp2f(x); }
__device__ __forceinline__ float sigmoidf_(float x) { return fast_rcp(1.f + fast_exp2(-x * LOG2E)); }
__device__ __forceinline__ float siluf_(float x) { return x * sigmoidf_(x); }
__device__ __forceinline__ float gelu_tanh(float x) { const float t = 1.5957691216057308f * (x + 0.044715f * x * x * x); return x * sigmoidf_(t); }
__device__ __forceinline__ int crow(int r, int hi) { return (r & 3) + 8 * (r >> 2) + 4 * hi; }
__device__ __forceinline__ float wave_sum(float v) {
#pragma unroll
    for (int o = 1; o < 64; o <<= 1) v += __shfl_xor(v, o);
    return v;
}

namespace pg8 {
constexpr int BM = 256, BK = 64, HALF = 128, HTB = HALF * BK * 2, STAGE_BYTES = 8 * HTB, NXCD = 8, WGM = 8;
__host__ __device__ __forceinline__ int lds_byte(int r, int c) { const int st = (r >> 4) * 2 + (c >> 5), rr = r & 15, cc = c & 31, ob = rr * 64 + cc * 2; return st * 1024 + (ob ^ (((ob >> 9) & 1) << 5)); }
__host__ __device__ __forceinline__ void stage_rc(int b, int& R, int& C) { const int st = b / 1024, sb = b % 1024, swz = sb ^ (((sb >> 9) & 1) << 5); R = (st >> 1) * 16 + swz / 64; C = (st & 1) * 32 + (swz % 64) / 2; }
__host__ __device__ __forceinline__ int perm32(int rho) { const int n = rho >> 4, i = rho & 15; return 8 * (i >> 2) + 4 * n + (i & 3); }

struct Unit { int pm, pn; };
struct Gemm { const bf16* A; const bf16* Bt; int K, lda, ldb; };

struct StaticOrder {
    int nM, nN, nwg, G, c;
    __device__ void init(int M, int N, int G_, int c_) { nM = M / BM; nN = N / BM; nwg = nM * nN; G = G_; c = c_; }
    __device__ bool next(int i, Unit& u) const {
        const long L = (long)i * G + c; if (L >= nwg) return false;
        int wgid = (int)L; { const int q = nwg / NXCD, r = nwg % NXCD, xcd = wgid % NXCD, off = wgid / NXCD; wgid = (xcd < r ? xcd * (q + 1) : r * (q + 1) + (xcd - r) * q) + off; }
        const int nig = WGM * nN, gid = wgid / nig, fm = gid * WGM, gsz = (nM - fm) < WGM ? (nM - fm) : WGM;
        u.pm = fm + ((wgid % nig) % gsz); u.pn = (wgid % nig) / gsz; return true;
    }
};
template <class Epi, class Sched, bool ALIGN_EPI = false, bool SP2 = true>
__device__ __forceinline__ void gemm_phase(LAS unsigned char* lds, const Gemm g, const Sched& S, const Epi& E) {
    const int tid = threadIdx.x, wid = __builtin_amdgcn_readfirstlane(tid >> 6), lane = tid & 63, wr = wid >> 2, wc = wid & 3, fr = lane & 15, fq = lane >> 4;
    int K = g.K; asm volatile("" : "+s"(K)); const int nt = K / BK;
    unsigned voffA[2], voffB[2];
#pragma unroll
    for (int i = 0; i < 2; ++i) { int R, C; stage_rc(tid * 16 + i * 8192, R, C); const int Rb = Epi::PERM ? ((R & ~31) + perm32(R & 31)) : R;
        voffA[i] = (unsigned)(R * g.lda + C) * 2u; voffB[i] = (unsigned)(Rb * g.ldb + C) * 2u; }
    const size_t kstep = (size_t)(BK * 2);
    const size_t hsA = (size_t)HALF * g.lda * 2, hsB = (size_t)HALF * g.ldb * 2;
    const size_t tsA = 2 * hsA, tsB = 2 * hsB;
    const unsigned ldsw = (unsigned)wid * 1024u;
    const int aoff = lds_byte(wr * 64 + fr, fq * 8), boff = lds_byte(wc * 32 + fr, fq * 8);
#define PG8_SA(b, h) (((b) * 2 + (h)) * HTB)
#define PG8_SB(b, h) ((4 + (b) * 2 + (h)) * HTB)
#define PG8_STAGE(bufoff, gbase, voff) do { _Pragma("unroll") for (int _i = 0; _i < 2; ++_i) \
        __builtin_amdgcn_global_load_lds((const unsigned*)((const char*)(gbase) + (voff)[_i]), (LAS unsigned*)(lds + (bufoff) + ldsw + _i * 8192), 16, 0, 0); } while (0)
#define PG8_LDA(dst, b, h) do { _Pragma("unroll") for (int m = 0; m < 4; ++m) _Pragma("unroll") for (int k = 0; k < 2; ++k) dst[m][k] = *(const LAS bf16x8*)(lds + PG8_SA(b, h) + aoff + m * 2048 + k * 1024); } while (0)
#define PG8_LDB(dst, b, h) do { _Pragma("unroll") for (int n = 0; n < 2; ++n) _Pragma("unroll") for (int k = 0; k < 2; ++k) dst[n][k] = *(const LAS bf16x8*)(lds + PG8_SB(b, h) + boff + n * 2048 + k * 1024); } while (0)
#define PG8_MMA(ai, bj, At, Bt) do { __builtin_amdgcn_s_setprio(1); _Pragma("unroll") for (int m = 0; m < 4; ++m) _Pragma("unroll") for (int n = 0; n < 2; ++n) _Pragma("unroll") for (int k = 0; k < 2; ++k) \
        acc[ai][bj][m][n] = __builtin_amdgcn_mfma_f32_16x16x32_bf16(Bt[n][k], At[m][k], acc[ai][bj][m][n], 0, 0, 0); __builtin_amdgcn_s_setprio(0); } while (0)
#define PG8_WAIT_V(n) asm volatile("s_waitcnt vmcnt(" #n ")" ::: "memory")
#define PG8_WAIT_L(n) asm volatile("s_waitcnt lgkmcnt(" #n ")" ::: "memory")
#define PG8_BAR __builtin_amdgcn_s_barrier()
#define PG8_SCHED __builtin_amdgcn_sched_barrier(0)
    Unit cur, nxt; int ui = 0;
    if (!S.next(0, cur)) return;
    f32x4 acc[2][2][4][2];
#pragma unroll
    for (int a = 0; a < 2; ++a)
#pragma unroll
        for (int b = 0; b < 2; ++b)
#pragma unroll
            for (int m = 0; m < 4; ++m)
#pragma unroll
                for (int n = 0; n < 2; ++n) acc[a][b][m][n] = (f32x4){0.f, 0.f, 0.f, 0.f};
    bf16x8 At[4][2], B0[2][2], B1[2][2];
    const char* cA = (const char*)g.A + (size_t)cur.pm * tsA; const char* cB = (const char*)g.Bt + (size_t)cur.pn * tsB;
    if constexpr (SP2) {
        PG8_STAGE(PG8_SB(0, 0), cB, voffB); PG8_STAGE(PG8_SB(0, 1), cB + hsB, voffB); PG8_STAGE(PG8_SA(0, 0), cA, voffA); PG8_STAGE(PG8_SA(0, 1), cA + hsA, voffA);
        if (wr == 1) PG8_BAR;
        PG8_WAIT_V(2); PG8_BAR;
        PG8_STAGE(PG8_SB(1, 0), cB + kstep, voffB); PG8_STAGE(PG8_SA(1, 0), cA + kstep, voffA); PG8_STAGE(PG8_SB(1, 1), cB + hsB + kstep, voffB);
        PG8_WAIT_V(6); PG8_BAR;
    } else {
        PG8_STAGE(PG8_SB(0, 0), cB, voffB); PG8_STAGE(PG8_SA(0, 0), cA, voffA); PG8_STAGE(PG8_SB(0, 1), cB + hsB, voffB); PG8_STAGE(PG8_SA(0, 1), cA + hsA, voffA);
        if (wr == 1) PG8_BAR;
        PG8_WAIT_V(4); PG8_BAR;
        PG8_STAGE(PG8_SB(1, 0), cB + kstep, voffB); PG8_STAGE(PG8_SA(1, 0), cA + kstep, voffA); PG8_STAGE(PG8_SB(1, 1), cB + hsB + kstep, voffB);
        PG8_WAIT_V(6); PG8_BAR;
    }
    for (;;) {
        const bool has_next = S.next(ui + 1, nxt);
        const char* nA = has_next ? (const char*)g.A + (size_t)nxt.pm * tsA : cA; const char* nB = has_next ? (const char*)g.Bt + (size_t)nxt.pn * tsB : cB;
        for (int t = 0; t < nt; t += 2) {
            const bool last = (t == nt - 2);
            const char* a1 = cA + (size_t)(t + 1) * kstep;
            const char* a2 = last ? nA : cA + (size_t)(t + 2) * kstep; const char* b2 = last ? nB : cB + (size_t)(t + 2) * kstep;
            const char* a3 = a2 + kstep; const char* b3 = b2 + kstep;
            if constexpr (SP2) {
            PG8_LDB(B0, 0, 0); PG8_LDB(B1, 0, 1); PG8_SCHED; PG8_LDA(At, 0, 0); PG8_STAGE(PG8_SA(1, 1), a1 + hsA, voffA);
            PG8_WAIT_V(8); PG8_WAIT_L(0); PG8_BAR; PG8_MMA(0, 0, At, B0); PG8_MMA(0, 1, At, B1); PG8_BAR; PG8_SCHED;
            PG8_LDA(At, 0, 1); PG8_STAGE(PG8_SB(0, 0), b2, voffB); PG8_STAGE(PG8_SB(0, 1), b2 + hsB, voffB); PG8_STAGE(PG8_SA(0, 0), a2, voffA);
            PG8_WAIT_V(8); PG8_WAIT_L(0); PG8_BAR; PG8_MMA(1, 0, At, B0); PG8_MMA(1, 1, At, B1); PG8_BAR; PG8_SCHED;
            PG8_LDB(B0, 1, 0); PG8_LDB(B1, 1, 1); PG8_SCHED; PG8_LDA(At, 1, 0); PG8_STAGE(PG8_SA(0, 1), a2 + hsA, voffA);
            PG8_WAIT_V(8); PG8_WAIT_L(0); PG8_BAR; PG8_MMA(0, 0, At, B0); PG8_MMA(0, 1, At, B1); PG8_BAR; PG8_SCHED;
            PG8_LDA(At, 1, 1); PG8_STAGE(PG8_SB(1, 0), b3, voffB); PG8_STAGE(PG8_SB(1, 1), b3 + hsB, voffB); PG8_STAGE(PG8_SA(1, 0), a3, voffA);
            PG8_WAIT_V(8); PG8_WAIT_L(0); PG8_BAR; PG8_MMA(1, 0, At, B0); PG8_MMA(1, 1, At, B1); PG8_BAR; PG8_SCHED;
            } else {
            PG8_LDB(B0, 0, 0); PG8_SCHED; PG8_LDA(At, 0, 0); PG8_STAGE(PG8_SA(1, 1), a1 + hsA, voffA);
            PG8_WAIT_L(8); PG8_BAR; PG8_WAIT_L(0); PG8_MMA(0, 0, At, B0); PG8_BAR; PG8_SCHED;
            PG8_LDB(B1, 0, 1); PG8_STAGE(PG8_SB(0, 0), b2, voffB);
            PG8_BAR; PG8_WAIT_L(0); PG8_MMA(0, 1, At, B1); PG8_BAR;
            PG8_LDA(At, 0, 1); PG8_STAGE(PG8_SA(0, 0), a2, voffA);
            PG8_BAR; PG8_WAIT_L(0); PG8_MMA(1, 0, At, B0); PG8_BAR; PG8_SCHED;
            PG8_STAGE(PG8_SB(0, 1), b2 + hsB, voffB);
            PG8_WAIT_V(6); PG8_BAR; PG8_MMA(1, 1, At, B1); PG8_BAR;
            PG8_LDB(B0, 1, 0); PG8_SCHED; PG8_LDA(At, 1, 0); PG8_STAGE(PG8_SA(0, 1), a2 + hsA, voffA);
            PG8_WAIT_L(8); PG8_BAR; PG8_WAIT_L(0); PG8_MMA(0, 0, At, B0); PG8_BAR; PG8_SCHED;
            PG8_LDB(B1, 1, 1); PG8_STAGE(PG8_SB(1, 0), b3, voffB);
            PG8_BAR; PG8_WAIT_L(0); PG8_MMA(0, 1, At, B1); PG8_BAR;
            PG8_LDA(At, 1, 1); PG8_STAGE(PG8_SA(1, 0), a3, voffA);
            PG8_BAR; PG8_WAIT_L(0); PG8_MMA(1, 0, At, B0); PG8_BAR; PG8_SCHED;
            PG8_STAGE(PG8_SB(1, 1), b3 + hsB, voffB);
            PG8_WAIT_V(6); PG8_BAR; PG8_MMA(1, 1, At, B1); PG8_BAR;
            }
        }
        if constexpr (ALIGN_EPI) { if (wr == 0) PG8_BAR; }
        if constexpr (!Epi::AFTER_DRAIN) { E(acc, cur, wr, wc, fr, fq); }
        if (!has_next) break;
#pragma unroll
        for (int a = 0; a < 2; ++a)
#pragma unroll
            for (int b = 0; b < 2; ++b)
#pragma unroll
                for (int m = 0; m < 4; ++m)
#pragma unroll
                    for (int n = 0; n < 2; ++n) acc[a][b][m][n] = (f32x4){0.f, 0.f, 0.f, 0.f};
        cur = nxt; cA = nA; cB = nB; ++ui;
        if constexpr (ALIGN_EPI) { if (wr == 1) PG8_BAR; }
    }
    PG8_WAIT_V(0);
    if constexpr (!ALIGN_EPI) { if (wr == 0) PG8_BAR; }
    PG8_BAR;
    if constexpr (Epi::AFTER_DRAIN) { E.fused(acc, cur, wr, wc, fr, fq, lds, wid, lane); }
#undef PG8_SA
#undef PG8_SB
#undef PG8_STAGE
#undef PG8_LDA
#undef PG8_LDB
#undef PG8_MMA
#undef PG8_WAIT_V
#undef PG8_WAIT_L
#undef PG8_BAR
#undef PG8_SCHED
}
}

#define XB_TMO      128
#define XB_XCNT(j)  (256  + 64 * (j))
#define XB_XSUB(j)  (1280 + 64 * (j))
#define XB_XGEN(j)  (2304 + 64 * (j))
#define XB_TOP      3328
#define XB_TOPGEN   3392
#define XCD_BAR_WORDS 3456
#define XB_SPIN_CAP (1u << 18)
__device__ __forceinline__ unsigned xb_ld(unsigned* p)              { return __hip_atomic_load(p, __ATOMIC_RELAXED, __HIP_MEMORY_SCOPE_AGENT); }
__device__ __forceinline__ unsigned xb_add(unsigned* p, unsigned v) { return __hip_atomic_fetch_add(p, v, __ATOMIC_RELAXED, __HIP_MEMORY_SCOPE_AGENT); }
__device__ __forceinline__ unsigned xb_xcc_id() { return (unsigned)__builtin_amdgcn_s_getreg((3 << 11) | 20) & 0xFu; }
#define XB_SPIN(cond, bar) do { unsigned _sp = 0; while (cond) { __builtin_amdgcn_s_sleep(1); \
    if ((++_sp & 255u) == 0u) { if (xb_ld(&(bar)[XB_TMO])) break; if (_sp > XB_SPIN_CAP) { atomicAdd(&(bar)[XB_TMO], 1u); break; } } } } while (0)
struct XcdBarrier { unsigned* bar; unsigned x; volatile LAS unsigned* st; };
__device__ __forceinline__ XcdBarrier xcd_barrier_post(unsigned* bar, volatile LAS unsigned* st) {
    XcdBarrier b; b.bar = bar; b.x = xb_xcc_id(); b.st = st;
    if (threadIdx.x == 0) (void)xb_add(&bar[XB_XCNT(b.x)], 1u);
    return b;
}
__device__ __forceinline__ void xcd_barrier_complete(unsigned* bar, unsigned x, unsigned& nloc, unsigned& nx) {
    const unsigned G = gridDim.x * gridDim.y * gridDim.z;
    unsigned sum, cnt, mine, sp = 0u;
    for (;;) {
        sum = 0u; cnt = 0u; mine = 0u;
#pragma unroll
        for (unsigned j = 0; j < 16; ++j) { const unsigned c = xb_ld(&bar[XB_XCNT(j)]); sum += c; cnt += (c > 0u) ? 1u : 0u; mine = (j == x) ? c : mine; }
        if (sum == G) break;
        __builtin_amdgcn_s_sleep(1);
        if ((++sp & 255u) == 0u) { if (xb_ld(&bar[XB_TMO])) break; if (sp > XB_SPIN_CAP) { atomicAdd(&bar[XB_TMO], 1u); break; } }
    }
    nloc = mine > 0u ? mine : 1u; nx = cnt > 0u ? cnt : 1u;
}
__device__ __forceinline__ void xcd_barrier(const XcdBarrier& b) {
    asm volatile("s_waitcnt vmcnt(0)" ::: "memory");
    __syncthreads();
    if (threadIdx.x == 0) {
        unsigned* bar = b.bar;
        __builtin_amdgcn_s_waitcnt(0);
        unsigned nloc = b.st[0], nx = b.st[1];
        if (nloc == 0u) { xcd_barrier_complete(bar, b.x, nloc, nx); b.st[0] = nloc; b.st[1] = nx; }
        const unsigned old = xb_add(&bar[XB_XSUB(b.x)], 1u);
        const unsigned gen = old / nloc;
        if (old + 1u == (gen + 1u) * nloc) {
            __builtin_amdgcn_fence(__ATOMIC_RELEASE, "agent");
            asm volatile("s_waitcnt vmcnt(0)" ::: "memory");
            const unsigned og = xb_add(&bar[XB_TOP], 1u);
            const unsigned tg = og / nx;
            if (og + 1u == (tg + 1u) * nx) xb_add(&bar[XB_TOPGEN], 1u);
            else XB_SPIN(xb_ld(&bar[XB_TOPGEN]) == tg, bar);
            __builtin_amdgcn_fence(__ATOMIC_ACQUIRE, "agent");
            xb_add(&bar[XB_XGEN(b.x)], 1u);
            asm volatile("s_waitcnt vmcnt(0)" ::: "memory");
        } else {
            XB_SPIN(xb_ld(&bar[XB_XGEN(b.x)]) == gen, bar);
            __builtin_amdgcn_fence(__ATOMIC_ACQUIRE, "agent");
            asm volatile("s_waitcnt vmcnt(0)" ::: "memory");
        }
    }
    __syncthreads();
}

constexpr size_t MiB = 1u << 20;
constexpr size_t WS_CTL = 0, CTL_ZERO_BYTES = 64 * 1024;
constexpr size_t WS_TAB   = 1 * MiB;
constexpr size_t TAB_ROPE = WS_TAB;
constexpr size_t TAB_BIAS = WS_TAB + 256 * 1024;
constexpr size_t TAB_A32  = WS_TAB + 272 * 1024;
constexpr size_t TAB_WS   = WS_TAB + 512 * 1024;
constexpr size_t TAB_S1   = 2 * MiB;
constexpr size_t TAB_S2   = 4 * MiB;
constexpr size_t WS_W     = 8 * MiB;
constexpr size_t W_A_IN = WS_W, W_A_GLU = W_A_IN + 4 * MiB, W_A_OUT = W_A_GLU + 2 * MiB, W_B_IN = W_A_OUT + 2 * MiB, W_B_OUT = W_B_IN + 4608 * 1024,
                 W_C_IN = W_B_OUT + 2 * MiB, W_C_ROPE = W_C_IN + 4 * MiB, W_C_UQ = W_C_ROPE + 64 * 1024, W_C_UKV = W_C_UQ + 2304 * 1024, W_C_OUT = W_C_UKV + 1 * MiB,
                 W_D_IN = W_C_OUT + 2 * MiB, W_D_OUT = W_D_IN + 6 * MiB, W_END = W_D_OUT + 2 * MiB;
static_assert(W_END <= 40 * MiB, "weights region");
constexpr size_t WS_XN = 40 * MiB;
constexpr size_t WS_Z  = 72 * MiB;
constexpr size_t WS_GT = 104 * MiB;
constexpr size_t WS_Y  = 136 * MiB;
constexpr size_t WS_L  = 168 * MiB;
constexpr size_t S5_BST = WS_L, S5_B2 = WS_L + 8 * MiB, S5_A2 = WS_L + 48 * MiB;
constexpr size_t SW_Q = WS_L, SW_KV = WS_L + 32 * MiB;
constexpr size_t ML_CQ = WS_L, ML_CKV = WS_L + 24 * MiB, ML_KR = WS_L + 32 * MiB, ML_Q = WS_L + 33 * MiB;
constexpr size_t ML_KN = WS_Y, ML_V = WS_XN;
constexpr size_t SG_U = WS_L, SG_V = WS_L + 32 * MiB;
constexpr size_t WS_END = 256 * MiB;
static_assert(S5_A2 + 40 * MiB <= WS_END && ML_Q + 48 * MiB <= WS_END, "ws map");
constexpr int CW_BAR = 4096;

constexpr int RING_BYTES = 131072, LDSCTL_OFF = RING_BYTES, LDS_BYTES = 147456;

struct Args { const float* in[31]; float* out; unsigned char* ws; int ph_lo, ph_hi; };

struct Ctx { LAS unsigned char* lds; int tid, lane, wave, vcu, G; };

#ifndef WT_STORES
#define WT_STORES 0
#endif
__device__ __forceinline__ void st16(bf16* p, u32x4 w) {
#if WT_STORES
    asm volatile("global_store_dwordx4 %0, %1, off sc1\n\ts_nop 1" :: "v"(p), "v"(w) : "memory");
#else
    *(u32x4*)p = w;
#endif
}
__device__ __forceinline__ void st16f(float* p, f32x4 w) {
#if WT_STORES
    asm volatile("global_store_dwordx4 %0, %1, off sc1\n\ts_nop 1" :: "v"(p), "v"(w) : "memory");
#else
    *(f32x4*)p = w;
#endif
}
__device__ __forceinline__ void st8(bf16* p, u32x2 w) {
#if WT_STORES
    asm volatile("global_store_dwordx2 %0, %1, off sc1\n\ts_nop 1" :: "v"(p), "v"(w) : "memory");
#else
    *(u32x2*)p = w;
#endif
}
__device__ __forceinline__ u32x4 ld16(const bf16* p) { return *(const u32x4*)p; }

template <class Op> struct Epi8 {
    static constexpr bool PERM = true, AFTER_DRAIN = false;
    Op op;
    __device__ __forceinline__ void operator()(const f32x4 (&acc)[2][2][4][2], const pg8::Unit& u, int wr, int wc, int fr, int fq) const {
        const int row0 = u.pm * 256 + wr * 64 + fr, col0 = u.pn * 256 + wc * 32 + 8 * fq;
#pragma unroll
        for (int ai = 0; ai < 2; ++ai)
#pragma unroll
            for (int m = 0; m < 4; ++m) {
                const int row = row0 + ai * 128 + m * 16;
#pragma unroll
                for (int bj = 0; bj < 2; ++bj) {
                    const int col = col0 + bj * 128;
                    float v[8];
#pragma unroll
                    for (int j = 0; j < 4; ++j) { v[j] = acc[ai][bj][m][0][j]; v[4 + j] = acc[ai][bj][m][1][j]; }
                    op(row, col, v, fq);
                }
            }
    }
};

struct OpAin {
    bf16* A2; bf16* zb;
    __device__ __forceinline__ void operator()(int row, int col, float (&v)[8], int) const {
        if (col < 1024) { const int g = col >> 4, h0 = col & 15; st16(A2 + ((size_t)(g * 512 + (row >> 5))) * 640 + (row & 31) * 16 + h0, pack8(v)); }
        else { float s[8];
#pragma unroll
            for (int j = 0; j < 8; ++j) s[j] = siluf_(v[j]);
            st16(zb + (size_t)row * 1024 + (col - 1024), pack8(s)); }
    }
};
struct OpAy {
    const bf16* A2; const float* dsk; bf16* yact;
    __device__ __forceinline__ void operator()(int row, int col, float (&v)[8], int) const {
        const int g = row >> 9, rr = row & 511, cc = col & 511;
        const int token = (rr >> 6) * 2048 + (rr & 63) * 32 + (cc >> 4), ch = g * 16 + (cc & 15);
        float u8[8]; unpack8(ld16(A2 + (size_t)row * 640 + cc), u8);
        const f32x4 d0 = *(const f32x4*)(dsk + ch), d1 = *(const f32x4*)(dsk + ch + 4);
        float o[8];
#pragma unroll
        for (int j = 0; j < 4; ++j) { o[j] = gelu_tanh(v[j] + d0[j] * u8[j]); o[4 + j] = gelu_tanh(v[4 + j] + d1[j] * u8[4 + j]); }
        st16(yact + (size_t)token * 1024 + ch, pack8(o));
    }
};
struct OpAglu {
    const bf16* yact; const bf16* zb; const float* bglu; bf16* gt;
    __device__ __forceinline__ void operator()(int row, int col, float (&v)[8], int) const {
        const size_t off = (size_t)row * 1024 + col;
        float y[8], z[8]; unpack8(ld16(yact + off), y); unpack8(ld16(zb + off), z);
        const f32x4 b0 = *(const f32x4*)(bglu + col), b1 = *(const f32x4*)(bglu + col + 4);
        float o[8];
#pragma unroll
        for (int j = 0; j < 4; ++j) { o[j] = y[j] * sigmoidf_(v[j] + b0[j]) * z[j]; o[4 + j] = y[4 + j] * sigmoidf_(v[4 + j] + b1[j]) * z[4 + j]; }
        st16(gt + off, pack8(o));
    }
};
struct OpOut {
    bf16* Y;
    __device__ __forceinline__ void operator()(int row, int col, float (&v)[8], int) const { st16(Y + (size_t)row * 1024 + col, pack8(v)); }
};
constexpr float QS_SWA = 0.125f * LOG2E;
struct OpBin {
    bf16* q; bf16* kv; bf16* zb;
    __device__ __forceinline__ void operator()(int row, int col, float (&v)[8], int) const {
        if (col < 1024) { float s[8];
#pragma unroll
            for (int j = 0; j < 8; ++j) s[j] = v[j] * QS_SWA;
            st16(q + (size_t)row * 1024 + col, pack8(s)); }
        else if (col < 1280) { st16(kv + (size_t)row * 256 + (col - 1024), pack8(v)); }
        else { float s[8];
#pragma unroll
            for (int j = 0; j < 8; ++j) s[j] = siluf_(v[j]);
            st16(zb + (size_t)row * 1024 + (col - 1280), pack8(s)); }
    }
};
struct OpCin {
    bf16* cq; bf16* ckv; bf16* zb; float* ssq;
    __device__ __forceinline__ void operator()(int row, int col, float (&v)[8], int fq) const {
        if (col < 1024) {
            float s = 0.f;
#pragma unroll
            for (int j = 0; j < 8; ++j) s += v[j] * v[j];
            s += __shfl_xor(s, 16); s += __shfl_xor(s, 32);
            if (fq == 0) ssq[(size_t)(col >> 5) * MTOK + row] = s;
            if (col < 768) st16(cq + (size_t)row * 768 + col, pack8(v)); else st16(ckv + (size_t)row * 256 + (col - 768), pack8(v));
        } else { float s[8];
#pragma unroll
            for (int j = 0; j < 8; ++j) s[j] = siluf_(v[j]);
            st16(zb + (size_t)row * 1024 + (col - 1024), pack8(s)); }
    }
};
struct OpDin {
    bf16* ub; bf16* vb; bf16* zb; float* ssum; float* ssq;
    __device__ __forceinline__ void operator()(int row, int col, float (&v)[8], int fq) const {
        float s[8];
        if (col < 2048) {
#pragma unroll
            for (int j = 0; j < 8; ++j) s[j] = gelu_tanh(v[j]);
            if (col < 1024) st16(ub + (size_t)row * 1024 + col, pack8(s));
            else {
                float a = 0.f, q = 0.f;
#pragma unroll
                for (int j = 0; j < 8; ++j) { a += s[j]; q += s[j] * s[j]; }
                a += __shfl_xor(a, 16); a += __shfl_xor(a, 32); q += __shfl_xor(q, 16); q += __shfl_xor(q, 32);
                if (fq == 0) { const size_t so = (size_t)((col - 1024) >> 5) * MTOK + row; ssum[so] = a; ssq[so] = q; }
                st16(vb + (size_t)row * 1024 + (col - 1024), pack8(s));
            }
        } else {
#pragma unroll
            for (int j = 0; j < 8; ++j) s[j] = siluf_(v[j]);
            st16(zb + (size_t)row * 1024 + (col - 2048), pack8(s));
        }
    }
};

constexpr float QS_MLA = 0.10206207261596577f * LOG2E;
struct OpQ {
    bf16* Q;
    __device__ __forceinline__ void operator()(int row, int col, float (&v)[8], int) const { st16(Q + (size_t)row * 1536 + col, pack8(v)); }
};
struct EpiCukv {
    static constexpr bool PERM = true, AFTER_DRAIN = false;
    const float* ssq; bf16* KN; bf16* V;
    __device__ __forceinline__ void operator()(const f32x4 (&acc)[2][2][4][2], const pg8::Unit& u, int wr, int wc, int fr, int fq) const {
        const int row0 = u.pm * 256 + wr * 64 + fr, col0 = u.pn * 256 + wc * 32 + 8 * fq;
#pragma unroll
        for (int ai = 0; ai < 2; ++ai)
#pragma unroll
            for (int m = 0; m < 4; ++m) {
                const int row = row0 + ai * 128 + m * 16;
                float s = ssq[(size_t)(24 + fq * 2) * MTOK + row] + ssq[(size_t)(24 + fq * 2 + 1) * MTOK + row];
                s += __shfl_xor(s, 16); s += __shfl_xor(s, 32);
                const float rs = rsqrtf(s * (1.f / 256.f) + EPS);
#pragma unroll
                for (int bj = 0; bj < 2; ++bj) {
                    const int col = col0 + bj * 128;
                    float v[8];
#pragma unroll
                    for (int j = 0; j < 4; ++j) { v[j] = acc[ai][bj][m][0][j] * rs; v[4 + j] = acc[ai][bj][m][1][j] * rs; }
                    if (col < 1024) st16(KN + (size_t)row * 1024 + col, pack8(v)); else st16(V + (size_t)row * 1024 + (col - 1024), pack8(v));
                }
            }
    }
};
struct EpiAscan {
    static constexpr bool PERM = false, AFTER_DRAIN = true;
    const float* a32; bf16* A2;
    __device__ __forceinline__ void fused(const f32x4 (&acc)[2][2][4][2], const pg8::Unit& u, int wr, int wc, int fr, int fq, LAS unsigned char* lds, int wid, int lane) const {
        const int g = u.pm >> 1, rm = u.pm & 1; const bool sel = (g & 1) != 0;
        LAS float* T = (LAS float*)lds;
#pragma unroll
        for (int ai = 0; ai < 2; ++ai)
#pragma unroll
            for (int m = 0; m < 4; ++m)
#pragma unroll
                for (int n = 0; n < 2; ++n) {
                    const int rl = ai * 128 + wr * 64 + m * 16 + fr, c = wc * 32 + n * 16 + 4 * fq;
                    const f32x4 v = sel ? acc[ai][1][m][n] : acc[ai][0][m][n];
                    *(LAS f32x4*)(T + rl * 128 + c) = v;
                }
        __syncthreads();
        const int tid = wid * 64 + lane;
        if (tid < 256) {
            const int bl = tid >> 6, p = tid & 63;
            const float are = a32[(g * 64 + p) * 2], aim = a32[(g * 64 + p) * 2 + 1];
            float sre = 0.f, sim = 0.f;
            bf16* dst = A2 + ((size_t)(g * 512 + (rm * 4 + bl) * 64)) * 640 + 512 + p;
            const LAS float* src = T + (bl * 64) * 128 + p;
            for (int c = 0; c < 64; ++c) {
                dst[(size_t)c * 640] = f2bf(sre); dst[(size_t)c * 640 + 64] = f2bf(sim);
                const float xre = src[c * 128], xim = src[c * 128 + 64];
                const float nre = are * sre - aim * sim + xre, nim = are * sim + aim * sre + xim;
                sre = nre; sim = nim;
            }
        }
        __syncthreads();
    }
};
struct OrderUkv { int bx; __device__ bool next(int i, pg8::Unit& u) const { int L; if (bx >= 128) { if (i >= 3) return false; L = (bx - 128) * 3 + i; } else { if (i >= 1) return false; L = 384 + bx; }
    u.pm = L >> 3; u.pn = L & 7; return true; } };
struct OrderS5a { int vcu, G; __device__ bool next(int i, pg8::Unit& u) const { const int L = i * G + vcu; if (L >= 128) return false; const int g = L >> 1; u.pm = 2 * g + (L & 1); u.pn = g >> 1; return true; } };
struct OrderS5b { int vcu, G; __device__ bool next(int i, pg8::Unit& u) const { const int L = i * G + vcu; if (L >= 256) return false; const int g = L >> 2; u.pm = 2 * g + ((L >> 1) & 1); u.pn = 2 * g + (L & 1); return true; } };

struct TItem { const float* W; const float* gain; bf16* WT; int ldw, K, src_col0, dst_row0, kb; };
__device__ __forceinline__ void titem_load(const TItem& t, int lane, f32x4 (&w)[8], float (&gv)[8]) {
    const int k0 = 64 * t.kb, c4 = (lane & 7) * 4, kr = lane >> 3;
#pragma unroll
    for (int i = 0; i < 8; ++i) { w[i] = *(const f32x4*)(t.W + (size_t)(k0 + kr + 8 * i) * t.ldw + t.src_col0 + c4); gv[i] = t.gain ? t.gain[k0 + kr + 8 * i] : 1.f; }
}
__device__ __forceinline__ void titem_store(const TItem& t, int lane, const f32x4 (&w)[8], const float (&gv)[8], LAS float* scr) {
    const int k0 = 64 * t.kb, c4 = (lane & 7) * 4, kr = lane >> 3;
#pragma unroll
    for (int i = 0; i < 8; ++i) { LAS float* d = scr + (kr + 8 * i) * 33 + c4; d[0] = w[i].x * gv[i]; d[1] = w[i].y * gv[i]; d[2] = w[i].z * gv[i]; d[3] = w[i].w * gv[i]; }
    asm volatile("s_waitcnt lgkmcnt(0)" ::: "memory");
    const int c = lane & 7;
#pragma unroll
    for (int j = 0; j < 4; ++j) { const int n = (lane >> 3) + 8 * j; const LAS float* s = scr + (8 * c) * 33 + n;
        u32x4 o; o.x = cvt_pk_bf16(s[0 * 33], s[1 * 33]); o.y = cvt_pk_bf16(s[2 * 33], s[3 * 33]); o.z = cvt_pk_bf16(s[4 * 33], s[5 * 33]); o.w = cvt_pk_bf16(s[6 * 33], s[7 * 33]);
        *(u32x4*)(t.WT + (size_t)(t.dst_row0 + n) * t.K + k0 + 8 * c) = o; }
    asm volatile("s_waitcnt lgkmcnt(0)" ::: "memory");
}
__device__ __forceinline__ void rms_rows2_to_bf16(const float* xa, const float* xb, bf16* oa, bf16* ob, int lane) {
    const f32x4* xr0 = (const f32x4*)xa + lane; const f32x4* xr1 = (const f32x4*)xb + lane;
    f32x4 v[4], w[4]; float s = 0.f, s2 = 0.f;
#pragma unroll
    for (int j = 0; j < 4; ++j) { v[j] = xr0[64 * j]; w[j] = xr1[64 * j]; }
#pragma unroll
    for (int j = 0; j < 4; ++j) { s += (v[j].x * v[j].x + v[j].y * v[j].y) + (v[j].z * v[j].z + v[j].w * v[j].w); s2 += (w[j].x * w[j].x + w[j].y * w[j].y) + (w[j].z * w[j].z + w[j].w * w[j].w); }
    const float r = rsqrtf(wave_sum(s) * (1.f / 1024.f) + EPS), r2 = rsqrtf(wave_sum(s2) * (1.f / 1024.f) + EPS);
    u32x2* o8 = (u32x2*)oa + lane; u32x2* p8 = (u32x2*)ob + lane;
#pragma unroll
    for (int j = 0; j < 4; ++j) { u32x2 q; q.x = cvt_pk_bf16(v[j].x * r, v[j].y * r); q.y = cvt_pk_bf16(v[j].z * r, v[j].w * r); o8[64 * j] = q;
        u32x2 q2; q2.x = cvt_pk_bf16(w[j].x * r2, w[j].y * r2); q2.y = cvt_pk_bf16(w[j].z * r2, w[j].w * r2); p8[64 * j] = q2; }
}

constexpr int NI0 = 16 * 64, NI1 = 16 * 32, NI3 = 16 * 72, NI5 = 16 * 64, NI6 = 16, NI7 = 12 * 48, NI8 = 4 * 64, NI10 = 16 * 96;
constexpr int NITEMS = NI0 + NI1 * 2 + NI3 + NI1 + NI5 + NI6 + NI7 + NI8 + NI1 + NI10 + NI1;
__device__ __forceinline__ TItem titem_decode(const __attribute__((address_space(4))) Args& a, unsigned char* ws, int r) {
    TItem t;
#define TI(W_, LDW_, K_, SC_, G_, WT_, DR_, KB_) do { t.W = (W_); t.ldw = (LDW_); t.K = (K_); t.src_col0 = (SC_); t.gain = (G_); t.WT = (bf16*)(ws + (WT_)); t.dst_row0 = (DR_); t.kb = (KB_); return t; } while (0)
    if (r < NI0) { const int nb = 64, kb = r / nb, n0 = (r % nb) * 32; TI(a.in[4], 2048, 1024, n0, a.in[1], W_A_IN, n0, kb); } r -= NI0;
    if (r < NI1) { const int nb = 32, kb = r / nb, n0 = (r % nb) * 32; TI(a.in[13], 1024, 1024, n0, nullptr, W_A_GLU, n0, kb); } r -= NI1;
    if (r < NI1) { const int nb = 32, kb = r / nb, n0 = (r % nb) * 32; TI(a.in[15], 1024, 1024, n0, nullptr, W_A_OUT, n0, kb); } r -= NI1;
    if (r < NI3) { const int nb = 72, kb = r / nb, n0 = (r % nb) * 32; TI(a.in[16], 2304, 1024, n0, a.in[1] + 1024, W_B_IN, n0, kb); } r -= NI3;
    if (r < NI1) { const int nb = 32, kb = r / nb, n0 = (r % nb) * 32; TI(a.in[18], 1024, 1024, n0, nullptr, W_B_OUT, n0, kb); } r -= NI1;
    if (r < NI5) { const int nb = 64, kb = r / nb, n0 = (r % nb) * 32; TI(a.in[19], 2080, 1024, n0 < 1024 ? n0 : n0 + 32, a.in[1] + 2048, W_C_IN, n0, kb); } r -= NI5;
    if (r < NI6) { TI(a.in[19], 2080, 1024, 1024, a.in[1] + 2048, W_C_ROPE, 0, r); } r -= NI6;
    if (r < NI7) { const int nb = 48, kb = r / nb, n0 = (r % nb) * 32; TI(a.in[22], 1536, 768, n0, a.in[20], W_C_UQ, n0, kb); } r -= NI7;
    if (r < NI8) { const int nb = 64, kb = r / nb, n0 = (r % nb) * 32; const int sc = n0 < 1024 ? (n0 >> 6) * 128 + (n0 & 63) : ((n0 - 1024) >> 6) * 128 + 64 + (n0 & 63); TI(a.in[23], 2048, 256, sc, a.in[21], W_C_UKV, n0, kb); } r -= NI8;
    if (r < NI1) { const int nb = 32, kb = r / nb, n0 = (r % nb) * 32; TI(a.in[24], 1024, 1024, n0, nullptr, W_C_OUT, n0, kb); } r -= NI1;
    if (r < NI10) { const int nb = 96, kb = r / nb, n0 = (r % nb) * 32; TI(a.in[25], 3072, 1024, n0, a.in[1] + 3072, W_D_IN, n0, kb); } r -= NI10;
    { const int nb = 32, kb = r / nb, n0 = (r % nb) * 32; TI(a.in[30], 1024, 1024, n0, nullptr, W_D_OUT, n0, kb); }
#undef TI
}
__device__ __forceinline__ void prologue(const __attribute__((address_space(4))) Args* ap_, const Ctx& C, int it_lo, int it_hi, int cu_lo) {
    const __attribute__((address_space(4))) Args& a = *ap_;
    unsigned char* ws = a.ws;
    if (C.vcu < cu_lo) return;
    LAS float* scr = (LAS float*)(C.lds + C.wave * 16384);
    const int gw = (C.vcu - cu_lo) * NWAVES + C.wave, NGW = (C.G - cu_lo) * NWAVES;
    for (int it = it_lo + gw; it < it_hi; it += 2 * NGW) {
        const TItem t0 = titem_decode(a, ws, it);
        const bool two = (it + NGW) < it_hi;
        const TItem t1 = titem_decode(a, ws, two ? it + NGW : it);
        f32x4 w0[8], w1[8]; float g0[8], g1[8];
        titem_load(t0, C.lane, w0, g0); titem_load(t1, C.lane, w1, g1);
        titem_store(t0, C.lane, w0, g0, scr);
        if (two) titem_store(t1, C.lane, w1, g1, scr);
    }
}
__device__ __forceinline__ void prologue_tables(const __attribute__((address_space(4))) Args* ap_, const Ctx& C) {
    const __attribute__((address_space(4))) Args& a = *ap_;
    unsigned char* ws = a.ws;
    const int gw = C.vcu * NWAVES + C.wave, NGW = C.G * NWAVES;
    for (int m = gw; m < MTOK; m += 2 * NGW) { const int m2 = (m + NGW < MTOK) ? m + NGW : m;
        rms_rows2_to_bf16(a.in[0] + (size_t)m * 1024, a.in[0] + (size_t)m2 * 1024, (bf16*)(ws + WS_XN) + (size_t)m * 1024, (bf16*)(ws + WS_XN) + (size_t)m2 * 1024, C.lane); }
    {
        const int gt = C.vcu * NTHREADS + C.tid, NGT = C.G * NTHREADS;
        float* rc = (float*)(ws + TAB_ROPE); float* rsn = rc + 2048 * 16;
        for (int i = gt; i < 2048 * 16; i += NGT) {
            const int pos = i >> 4, j = i & 15;
            const float inv = exp2f(-(float)(2 * j) * (13.287712379549449f / 32.f));
            const float ang = (float)pos * inv;
            rc[i] = cosf(ang); rsn[i] = sinf(ang);
        }
        float* bt = (float*)(ws + TAB_BIAS);
        for (int i = gt; i < 16 * 128; i += NGT) {
            const int h = i >> 7, d = i & 127;
            int bk = d;
            if (d >= 16) { const float lg = logf((float)d / 16.f) / 2.0794415416798357f * 16.f; bk = 16 + (int)lg; if (bk > 31) bk = 31; }
            bt[i] = a.in[3][bk * 16 + h] * LOG2E;
        }
        bf16* wsb = (bf16*)(ws + TAB_WS);
        for (int i = gt; i < 16 * 128 * 16; i += NGT) {
            const int t = (i >> 4) & 127, s0 = (i & 15) * 8;
            const f32x4 w0 = *(const f32x4*)(a.in[28] + (size_t)i * 8), w1 = *(const f32x4*)(a.in[28] + (size_t)i * 8 + 4);
            float v[8] = {w0.x, w0.y, w0.z, w0.w, w1.x, w1.y, w1.z, w1.w};
#pragma unroll
            for (int j = 0; j < 8; ++j) if (s0 + j > t) v[j] = 0.f;
            st16(wsb + (size_t)i * 8, pack8(v));
        }
    }
}
__device__ __forceinline__ void prologue_s5(const __attribute__((address_space(4))) Args* ap_, const Ctx& C) {
    const __attribute__((address_space(4))) Args& a = *ap_;
    unsigned char* ws = a.ws;
    __syncthreads();
    LAS float* pw = (LAS float*)C.lds;
    LAS float* Bb = pw + 33 * 64 * 2;
    LAS float* Cc = Bb + 64 * 16 * 2;
    LAS float* Kq = Cc + 4 * 64 * 2;
    LAS float* Fz = Kq + 32 * 4 * 16;
    for (int bt = C.vcu; bt < 256; bt += C.G) {
        const int g = bt >> 2, q = bt & 3;
        const float dt = expf(a.in[7][g]);
        for (int i = C.tid; i < 33 * 64; i += NTHREADS) {
            const int tau = i >> 6, p = i & 63;
            const float lr = a.in[5][g * 64 + p], li = a.in[6][g * 64 + p];
            const float mag = fast_exp2(lr * dt * (float)tau * LOG2E);
            float rev = li * dt * (float)tau * 0.15915494309189535f; rev = rev - floorf(rev);
            pw[i * 2] = mag * __builtin_amdgcn_cosf(rev); pw[i * 2 + 1] = mag * __builtin_amdgcn_sinf(rev);
        }
        if (C.tid < 64) {
            const int p = C.tid;
            const float lr = a.in[5][g * 64 + p], li = a.in[6][g * 64 + p];
            const float zr = lr * dt, zi = li * dt;
            const float em1 = expm1f(zr), sh = sinf(0.5f * zi), cm1 = -2.f * sh * sh, sn = sinf(zi);
            const float nr = em1 * (1.f + cm1) + cm1, ni = (1.f + em1) * sn;
            const float den = lr * lr + li * li;
            Fz[p * 2] = (nr * lr + ni * li) / den; Fz[p * 2 + 1] = (ni * lr - nr * li) / den;
        }
        for (int i = C.tid; i < 4 * 64; i += NTHREADS) {
            const int hl = i >> 6, p = i & 63;
            Cc[i * 2] = a.in[10][(size_t)g * 1024 + (4 * q + hl) * 64 + p]; Cc[i * 2 + 1] = a.in[11][(size_t)g * 1024 + (4 * q + hl) * 64 + p];
        }
        __syncthreads();
        for (int i = C.tid; i < 64 * 16; i += NTHREADS) {
            const int p = i >> 4;
            const float fre = Fz[p * 2], fim = Fz[p * 2 + 1];
            const float br = a.in[8][(size_t)g * 1024 + i], bi = a.in[9][(size_t)g * 1024 + i];
            Bb[i * 2] = fre * br - fim * bi; Bb[i * 2 + 1] = fre * bi + fim * br;
        }
        __syncthreads();
        for (int i = C.tid; i < 32 * 64; i += NTHREADS) {
            const int tau = i >> 6, hl = (i >> 4) & 3, h = i & 15;
            float s = 0.f;
#pragma unroll 8
            for (int p = 0; p < 64; ++p) {
                const f32x2 cc = *(const LAS f32x2*)(Cc + (hl * 64 + p) * 2), aa = *(const LAS f32x2*)(pw + (tau * 64 + p) * 2), bb = *(const LAS f32x2*)(Bb + (p * 16 + h) * 2);
                const float tr = cc.x * aa.x - cc.y * aa.y, ti = cc.x * aa.y + cc.y * aa.x;
                s += tr * bb.x - ti * bb.y;
            }
            Kq[i] = s;
        }
        __syncthreads();
        bf16* B2 = (bf16*)(ws + S5_B2) + (size_t)(g * 512) * 640;
        for (int i = C.tid; i < 128 * 80; i += NTHREADS) {
            const int rl = i / 80, ch = i % 80, j = rl >> 2, hl = rl & 3;
            float v[8];
            if (ch < 64) { const int ii = ch >> 1, h0 = (ch & 1) * 8;
                if (ii <= j) { const LAS float* kp = Kq + ((j - ii) * 4 + hl) * 16 + h0; const f32x4 k0 = *(const LAS f32x4*)kp, k1 = *(const LAS f32x4*)(kp + 4);
                    v[0] = k0.x; v[1] = k0.y; v[2] = k0.z; v[3] = k0.w; v[4] = k1.x; v[5] = k1.y; v[6] = k1.z; v[7] = k1.w; }
                else {
#pragma unroll
                    for (int e = 0; e < 8; ++e) v[e] = 0.f; }
            } else { const int p0 = ((ch - 64) * 8) & 63; const bool im = ch >= 72;
#pragma unroll
                for (int e = 0; e < 8; ++e) { const int p = p0 + e; const float cr = Cc[(hl * 64 + p) * 2], ci = Cc[(hl * 64 + p) * 2 + 1], ar = pw[((j + 1) * 64 + p) * 2], ai = pw[((j + 1) * 64 + p) * 2 + 1];
                    v[e] = im ? -(cr * ai + ci * ar) : (cr * ar - ci * ai); }
            }
            st16(B2 + (size_t)(j * 16 + 4 * q + hl) * 640 + ch * 8, pack8(v));
        }
        bf16* Bs = (bf16*)(ws + S5_BST) + (size_t)(g * 128 + q * 32) * 512;
        for (int i = C.tid; i < 32 * 64; i += NTHREADS) {
            const int r = q * 32 + (i >> 6), ch = i & 63, p = r & 63, ii = ch >> 1, h0 = (ch & 1) * 8;
            const float ar = pw[((31 - ii) * 64 + p) * 2], ai = pw[((31 - ii) * 64 + p) * 2 + 1];
            float v[8];
#pragma unroll
            for (int e = 0; e < 8; ++e) { const float br = Bb[(p * 16 + h0 + e) * 2], bi = Bb[(p * 16 + h0 + e) * 2 + 1]; v[e] = r < 64 ? (ar * br - ai * bi) : (ar * bi + ai * br); }
            st16(Bs + (size_t)(i >> 6) * 512 + ch * 8, pack8(v));
        }
        if (q == 0 && C.tid < 64) { float* a32 = (float*)(ws + TAB_A32); a32[(g * 64 + C.tid) * 2] = pw[(32 * 64 + C.tid) * 2]; a32[(g * 64 + C.tid) * 2 + 1] = pw[(32 * 64 + C.tid) * 2 + 1]; }
        __syncthreads();
    }
}

__device__ __forceinline__ void row_phase(const Ctx& C, const bf16* Y, const float* xin, float* xout, const float* gpost, bf16* XN, bool make_xn) {
    const int gw = C.vcu * NWAVES + C.wave, NGW = C.G * NWAVES;
    f32x4 gp[4];
#pragma unroll
    for (int j = 0; j < 4; ++j) gp[j] = *((const f32x4*)gpost + C.lane + 64 * j);
    for (int m = gw; m < MTOK; m += NGW) {
        const u32x2* yr = (const u32x2*)(Y + (size_t)m * 1024) + C.lane;
        const f32x4* xr = (const f32x4*)(xin + (size_t)m * 1024) + C.lane;
        f32x4 y[4], x[4]; float s = 0.f;
#pragma unroll
        for (int j = 0; j < 4; ++j) { const u32x2 w = yr[64 * j]; y[j] = (f32x4){bf_lo(w.x), bf_hi(w.x), bf_lo(w.y), bf_hi(w.y)}; x[j] = xr[64 * j];
            s += (y[j].x * y[j].x + y[j].y * y[j].y) + (y[j].z * y[j].z + y[j].w * y[j].w); }
        const float r = rsqrtf(wave_sum(s) * (1.f / 1024.f) + EPS);
        float s2 = 0.f;
#pragma unroll
        for (int j = 0; j < 4; ++j) { x[j] = x[j] + y[j] * r * gp[j]; s2 += (x[j].x * x[j].x + x[j].y * x[j].y) + (x[j].z * x[j].z + x[j].w * x[j].w); }
        float* xo = xout + (size_t)m * 1024 + 4 * C.lane;
#pragma unroll
        for (int j = 0; j < 4; ++j) st16f(xo + 256 * j, x[j]);
        if (make_xn) {
            const float r2 = rsqrtf(wave_sum(s2) * (1.f / 1024.f) + EPS);
            bf16* o8 = XN + (size_t)m * 1024 + 4 * C.lane;
#pragma unroll
            for (int j = 0; j < 4; ++j) { u32x2 w; w.x = cvt_pk_bf16(x[j].x * r2, x[j].y * r2); w.y = cvt_pk_bf16(x[j].z * r2, x[j].w * r2); st8(o8 + 256 * j, w); }
        }
    }
}

__device__ __forceinline__ void krope_phase(const Ctx& C, const bf16* XN, const bf16* Wr, const float* rcos, const float* rsin, bf16* KR) {
    const int gw = C.vcu * NWAVES + C.wave, NGW = C.G * NWAVES;
    const int fr = C.lane & 15, fq = C.lane >> 4;
    for (int task = gw; task < MTOK / 16; task += NGW) {
        const int m0 = task * 16;
        f32x4 acc0 = {0.f, 0.f, 0.f, 0.f}, acc1 = {0.f, 0.f, 0.f, 0.f};
        const bf16* ap = XN + (size_t)(m0 + fr) * 1024 + 8 * fq;
        const bf16* b0 = Wr + (size_t)fr * 1024 + 8 * fq; const bf16* b1 = Wr + (size_t)(16 + fr) * 1024 + 8 * fq;
#pragma unroll 4
        for (int ks = 0; ks < 32; ++ks) {
            const bf16x8 af = *(const bf16x8*)(ap + ks * 32), bf0 = *(const bf16x8*)(b0 + ks * 32), bf1 = *(const bf16x8*)(b1 + ks * 32);
            acc0 = __builtin_amdgcn_mfma_f32_16x16x32_bf16(af, bf0, acc0, 0, 0, 0);
            acc1 = __builtin_amdgcn_mfma_f32_16x16x32_bf16(af, bf1, acc1, 0, 0, 0);
        }
#pragma unroll
        for (int i = 0; i < 4; ++i) {
            const int row = m0 + 4 * fq + i, pos = row & 2047;
            const float cs = rcos[pos * 16 + fr], sn = rsin[pos * 16 + fr];
            const float x1 = acc0[i], x2 = acc1[i];
            KR[(size_t)row * 32 + fr] = f2bf(x1 * cs - x2 * sn);
            KR[(size_t)row * 32 + 16 + fr] = f2bf(x2 * cs + x1 * sn);
        }
    }
}

__device__ __forceinline__ bf16x8 pack_p(const f32x16& p, int s) {
    u32x4 w; w.x = cvt_pk_bf16(p[8 * s + 0], p[8 * s + 1]); w.y = cvt_pk_bf16(p[8 * s + 2], p[8 * s + 3]); w.z = cvt_pk_bf16(p[8 * s + 4], p[8 * s + 5]); w.w = cvt_pk_bf16(p[8 * s + 6], p[8 * s + 7]);
    return __builtin_bit_cast(bf16x8, w);
}
__device__ __forceinline__ bf16x8 ld_vt(const LAS bf16* p) {
    const u32x2 a = *(const LAS u32x2*)p, b = *(const LAS u32x2*)(p + 8);
    u32x4 w; w.x = a.x; w.y = a.y; w.z = b.x; w.w = b.y; return __builtin_bit_cast(bf16x8, w);
}
#define MFMA32(A, B, C) __builtin_amdgcn_mfma_f32_32x32x16_bf16((A), (B), (C), 0, 0, 0)

constexpr int SW_KP = 72, SW_VP = 264;
__device__ __forceinline__ void swa_phase(const Ctx& C, const bf16* Q, const bf16* KV, const bf16* Z, const float* btab, const float* sinks, bf16* GT) {
    LAS bf16* Kl = (LAS bf16*)C.lds;
    LAS bf16* Vt = Kl + 256 * SW_KP;
    LAS float* Bl = (LAS float*)(Vt + 64 * SW_VP);
    for (int i = C.tid; i < 16 * 200; i += NTHREADS) { const int h = i / 200, d = i % 200 - 36; Bl[i] = (d >= 0 && d < 128) ? btab[h * 128 + d] : -1e30f; }
    const int r = C.lane & 31, hi = C.lane >> 5;
    for (int su = C.vcu; su < 256; su += C.G) {
        const int blk = su & 15, kvh = (su >> 4) & 1, b = su >> 5;
        const int qs = blk * 128, hq = kvh * 8 + C.wave;
        bf16x8 qn[4]; u32x2 zn[8];
        { const bf16* qp = Q + (size_t)(b * 2048 + qs + r) * 1024 + hq * 64 + 8 * hi; const size_t ob0 = (size_t)(b * 2048 + qs + r) * 1024 + hq * 64 + 4 * hi;
#pragma unroll
          for (int s = 0; s < 4; ++s) qn[s] = *(const bf16x8*)(qp + 16 * s);
#pragma unroll
          for (int i4 = 0; i4 < 4; ++i4) { zn[i4] = *(const u32x2*)(Z + ob0 + 8 * i4); zn[4 + i4] = *(const u32x2*)(Z + ob0 + 32 + 8 * i4); } }
        __syncthreads();
        {
            u32x4 kk[4], vv[4];
#pragma unroll
            for (int i = 0; i < 4; ++i) {
                const int idx = C.tid + i * NTHREADS, key = idx >> 3, ch = idx & 7, pos = qs - 128 + key;
                kk[i] = (u32x4){0u, 0u, 0u, 0u}; vv[i] = kk[i];
                if (pos >= 0) { const bf16* src = KV + (size_t)(b * 2048 + pos) * 256 + kvh * 64 + ch * 8; kk[i] = ld16(src); vv[i] = ld16(src + 128); }
            }
#pragma unroll
            for (int i = 0; i < 4; ++i) {
                const int idx = C.tid + i * NTHREADS, key = idx >> 3, ch = idx & 7;
                *(LAS u32x4*)(Kl + key * SW_KP + ch * 8) = kk[i];
                LAS bf16* vd = Vt + (ch * 8) * SW_VP + key;
                vd[0 * SW_VP] = (bf16)(vv[i].x & 0xffff); vd[1 * SW_VP] = (bf16)(vv[i].x >> 16); vd[2 * SW_VP] = (bf16)(vv[i].y & 0xffff); vd[3 * SW_VP] = (bf16)(vv[i].y >> 16);
                vd[4 * SW_VP] = (bf16)(vv[i].z & 0xffff); vd[5 * SW_VP] = (bf16)(vv[i].z >> 16); vd[6 * SW_VP] = (bf16)(vv[i].w & 0xffff); vd[7 * SW_VP] = (bf16)(vv[i].w >> 16);
            }
        }
        __syncthreads();
        const float sink2 = sinks[hq] * LOG2E;
        for (int sj = 0; sj < 4; ++sj) {
            const int q0 = qs + 32 * sj;
            const LAS bf16* Ks = Kl + (32 * sj) * SW_KP; const LAS bf16* Vs = Vt + 32 * sj;
            const size_t ob = (size_t)(b * 2048 + q0 + r) * 1024 + hq * 64 + 4 * hi;
            bf16x8 qf[4]; u32x2 zg[8];
#pragma unroll
            for (int s = 0; s < 4; ++s) qf[s] = qn[s];
#pragma unroll
            for (int i = 0; i < 8; ++i) zg[i] = zn[i];
            if (sj + 1 < 4) { const bf16* qp = Q + (size_t)(b * 2048 + q0 + 32 + r) * 1024 + hq * 64 + 8 * hi;
#pragma unroll
                for (int s = 0; s < 4; ++s) qn[s] = *(const bf16x8*)(qp + 16 * s);
#pragma unroll
                for (int i4 = 0; i4 < 4; ++i4) { zn[i4] = *(const u32x2*)(Z + ob + 32 * 1024 + 8 * i4); zn[4 + i4] = *(const u32x2*)(Z + ob + 32 * 1024 + 32 + 8 * i4); } }
            f32x16 st[5];
#pragma unroll
            for (int t = 0; t < 5; ++t) {
                f32x16 acc = {0.f,0.f,0.f,0.f,0.f,0.f,0.f,0.f,0.f,0.f,0.f,0.f,0.f,0.f,0.f,0.f};
#pragma unroll
                for (int s = 0; s < 4; ++s) { const bf16x8 kf = *(const LAS bf16x8*)(Ks + (32 * t + r) * SW_KP + 16 * s + 8 * hi); acc = MFMA32(kf, qf[s], acc); }
                st[t] = acc;
            }
            float mx = sink2;
            const LAS float* bl = Bl + hq * 200 + (5 + r - 4 * hi);
#pragma unroll
            for (int t = 0; t < 5; ++t)
#pragma unroll
                for (int i = 0; i < 16; ++i) {
                    float sc = st[t][i] + bl[159 - (32 * t + (i & 3) + 8 * (i >> 2))];
                    if (q0 < 128) { if (q0 - 128 + 32 * t + crow(i, hi) < 0) sc = -1e30f; }
                    st[t][i] = sc; mx = fmaxf(mx, sc);
                }
            mx = fmaxf(mx, __shfl_xor(mx, 32));
            float l = 0.f;
#pragma unroll
            for (int t = 0; t < 5; ++t)
#pragma unroll
                for (int i = 0; i < 16; ++i) { const float p = fast_exp2(st[t][i] - mx); st[t][i] = p; l += p; }
            l += __shfl_xor(l, 32);
            l += fast_exp2(sink2 - mx);
            f32x16 o0 = {0.f,0.f,0.f,0.f,0.f,0.f,0.f,0.f,0.f,0.f,0.f,0.f,0.f,0.f,0.f,0.f}, o1 = o0;
#pragma unroll
            for (int t = 0; t < 5; ++t)
#pragma unroll
                for (int s = 0; s < 2; ++s) {
                    const bf16x8 pf = pack_p(st[t], s);
                    const bf16x8 v0 = ld_vt(Vs + r * SW_VP + 32 * t + 16 * s + 4 * hi), v1 = ld_vt(Vs + (32 + r) * SW_VP + 32 * t + 16 * s + 4 * hi);
                    o0 = MFMA32(v0, pf, o0); o1 = MFMA32(v1, pf, o1);
                }
            const float inv = fast_rcp(l);
#pragma unroll
            for (int i4 = 0; i4 < 4; ++i4) {
                const u32x2 z0 = zg[i4], z1 = zg[4 + i4];
                u32x2 w0, w1;
                w0.x = cvt_pk_bf16(o0[4 * i4 + 0] * inv * bf_lo(z0.x), o0[4 * i4 + 1] * inv * bf_hi(z0.x)); w0.y = cvt_pk_bf16(o0[4 * i4 + 2] * inv * bf_lo(z0.y), o0[4 * i4 + 3] * inv * bf_hi(z0.y));
                w1.x = cvt_pk_bf16(o1[4 * i4 + 0] * inv * bf_lo(z1.x), o1[4 * i4 + 1] * inv * bf_hi(z1.x)); w1.y = cvt_pk_bf16(o1[4 * i4 + 2] * inv * bf_lo(z1.y), o1[4 * i4 + 3] * inv * bf_hi(z1.y));
                st8(GT + ob + 8 * i4, w0); st8(GT + ob + 32 + 8 * i4, w1);
            }
        }
    }
    __syncthreads();
}

constexpr int ML_KP = 104, ML_VP = 136;
__device__ __forceinline__ void mla_phase(const Ctx& C, const bf16* Q, const bf16* KN, const bf16* KR, const bf16* V, const bf16* Z, const float* ssq, const float* rcos, const float* rsin, bf16* GT) {
    LAS bf16* Kb = (LAS bf16*)C.lds;
    LAS bf16* Vb = Kb + 2 * 128 * ML_KP;
    const int r = C.lane & 31, hi = C.lane >> 5;
    const int skey = C.tid >> 3, sch = C.tid & 7;
    const int rkey = C.tid >> 2, rch = C.tid & 3;
    int vo[2][4];
#pragma unroll
    for (int dt = 0; dt < 2; ++dt) { const int d = r + 32 * dt, swz = ((d >> 3) & 7) << 2;
#pragma unroll
        for (int e = 0; e < 4; ++e) vo[dt][e] = d * ML_VP + (((e >> 1) * 16 + 4 * hi + (e & 1) * 8) ^ swz); }
    for (int ui = 0; ui < 4; ++ui) {
        for (int base = C.vcu; base < 256; base += C.G) {
        const int bh = base >> 1, b = bh >> 4, hh = bh & 15;
        int qb;
        if ((base & 1) == 0) qb = (ui == 0) ? 7 : (ui == 1) ? 0 : (ui == 2) ? 6 : 1; else qb = (ui == 0) ? 5 : (ui == 1) ? 2 : (ui == 2) ? 4 : 3;
        const int q0w = qb * 256 + C.wave * 32;
        const int nsteps = 2 * (qb + 1);
        bf16x8 qf[6];
        { const int qrow = b * 2048 + q0w + r;
          const bf16* qp = Q + (size_t)qrow * 1536 + hh * 96 + 8 * hi;
          u32x4 qraw[6];
#pragma unroll
          for (int s = 0; s < 6; ++s) qraw[s] = ld16(qp + 16 * s);
          float ss = 0.f;
#pragma unroll
          for (int t = 0; t < 12; ++t) ss += ssq[(size_t)(hi * 12 + t) * MTOK + qrow];
          ss += __shfl_xor(ss, 32);
          const float qs = rsqrtf(ss * (1.f / 768.f) + EPS) * QS_MLA;
          const float* cp = rcos + (q0w + r) * 16 + 8 * hi; const float* sp = rsin + (q0w + r) * 16 + 8 * hi;
          const f32x4 c0 = *(const f32x4*)cp, c1 = *(const f32x4*)(cp + 4), s0v = *(const f32x4*)sp, s1v = *(const f32x4*)(sp + 4);
          float f4[8], f5[8]; unpack8(qraw[4], f4); unpack8(qraw[5], f5);
#pragma unroll
          for (int j = 0; j < 8; ++j) { const float cc = j < 4 ? c0[j] : c1[j - 4], sn = j < 4 ? s0v[j] : s1v[j - 4]; const float x1 = f4[j], x2 = f5[j]; f4[j] = (x1 * cc - x2 * sn) * qs; f5[j] = (x2 * cc + x1 * sn) * qs; }
#pragma unroll
          for (int s = 0; s < 4; ++s) { float f[8]; unpack8(qraw[s], f);
#pragma unroll
              for (int j = 0; j < 8; ++j) f[j] *= qs;
              qf[s] = __builtin_bit_cast(bf16x8, pack8(f)); }
          qf[4] = __builtin_bit_cast(bf16x8, pack8(f4)); qf[5] = __builtin_bit_cast(bf16x8, pack8(f5)); }
        const size_t ob = (size_t)(b * 2048 + q0w + r) * 1024 + hh * 64 + 4 * hi;
        u32x2 zg[8];
#pragma unroll
        for (int i4 = 0; i4 < 4; ++i4) { zg[i4] = *(const u32x2*)(Z + ob + 8 * i4); zg[4 + i4] = *(const u32x2*)(Z + ob + 32 + 8 * i4); }
        float mrun = -1e30f, lrun = 0.f;
        f32x16 o0 = {0.f,0.f,0.f,0.f,0.f,0.f,0.f,0.f,0.f,0.f,0.f,0.f,0.f,0.f,0.f,0.f}, o1 = o0;
        const bf16* knp = KN + (size_t)(b * 2048 + skey) * 1024 + hh * 64 + sch * 8;
        const bf16* vp  = V  + (size_t)(b * 2048 + skey) * 1024 + hh * 64 + sch * 8;
        const bf16* krp = KR + (size_t)(b * 2048 + rkey) * 32 + rch * 8;
        u32x4 gk0 = ld16(knp), gk1 = ld16(knp + 64 * 1024), gv0 = ld16(vp), gv1 = ld16(vp + 64 * 1024), gr = ld16(krp);
        for (int t = 0; t < nsteps; ++t) {
            const int bb = t & 1;
            LAS bf16* Kl = Kb + bb * 128 * ML_KP; LAS bf16* Vl = Vb + bb * 64 * ML_VP;
            *(LAS u32x4*)(Kl + skey * ML_KP + sch * 8) = gk0; *(LAS u32x4*)(Kl + (64 + skey) * ML_KP + sch * 8) = gk1;
            *(LAS u32x4*)(Kl + rkey * ML_KP + 64 + rch * 8) = gr;
            { LAS bf16* vd = Vl + (sch * 8) * ML_VP + (skey ^ (sch << 2));
              vd[0 * ML_VP] = (bf16)(gv0.x & 0xffff); vd[1 * ML_VP] = (bf16)(gv0.x >> 16); vd[2 * ML_VP] = (bf16)(gv0.y & 0xffff); vd[3 * ML_VP] = (bf16)(gv0.y >> 16);
              vd[4 * ML_VP] = (bf16)(gv0.z & 0xffff); vd[5 * ML_VP] = (bf16)(gv0.z >> 16); vd[6 * ML_VP] = (bf16)(gv0.w & 0xffff); vd[7 * ML_VP] = (bf16)(gv0.w >> 16);
              vd += 64;
              vd[0 * ML_VP] = (bf16)(gv1.x & 0xffff); vd[1 * ML_VP] = (bf16)(gv1.x >> 16); vd[2 * ML_VP] = (bf16)(gv1.y & 0xffff); vd[3 * ML_VP] = (bf16)(gv1.y >> 16);
              vd[4 * ML_VP] = (bf16)(gv1.z & 0xffff); vd[5 * ML_VP] = (bf16)(gv1.z >> 16); vd[6 * ML_VP] = (bf16)(gv1.w & 0xffff); vd[7 * ML_VP] = (bf16)(gv1.w >> 16); }
            __syncthreads();
            if (t + 1 < nsteps) { const size_t adv = (size_t)(t + 1) * 128; gk0 = ld16(knp + adv * 1024); gk1 = ld16(knp + (adv + 64) * 1024); gv0 = ld16(vp + adv * 1024); gv1 = ld16(vp + (adv + 64) * 1024); gr = ld16(krp + adv * 32); }
            const int k0 = t * 128;
            if (k0 <= q0w + 31) {
                f32x16 sc[4];
#pragma unroll
                for (int kt = 0; kt < 4; ++kt) sc[kt] = (f32x16){0.f,0.f,0.f,0.f,0.f,0.f,0.f,0.f,0.f,0.f,0.f,0.f,0.f,0.f,0.f,0.f};
                __builtin_amdgcn_s_setprio(1);
#pragma unroll
                for (int s = 0; s < 6; ++s)
#pragma unroll
                    for (int kt = 0; kt < 4; ++kt) { const bf16x8 kf = *(const LAS bf16x8*)(Kl + (32 * kt + r) * ML_KP + 16 * s + 8 * hi); sc[kt] = MFMA32(kf, qf[s], sc[kt]); }
                __builtin_amdgcn_s_setprio(0);
                if (k0 + 127 > q0w) {
                    const int qpos = q0w + r;
#pragma unroll
                    for (int kt = 0; kt < 4; ++kt)
#pragma unroll
                        for (int i = 0; i < 16; ++i) { if (k0 + 32 * kt + crow(i, hi) > qpos) sc[kt][i] = -1e30f; }
                }
                float tm = sc[0][0];
#pragma unroll
                for (int kt = 0; kt < 4; ++kt)
#pragma unroll
                    for (int i = 0; i < 16; ++i) tm = fmaxf(tm, sc[kt][i]);
                tm = fmaxf(tm, __shfl_xor(tm, 32));
                if (!__all(tm <= mrun)) {
                    const float mn = fmaxf(mrun, tm), alpha = fast_exp2(mrun - mn);
                    mrun = mn; lrun *= alpha;
#pragma unroll
                    for (int i = 0; i < 16; ++i) { o0[i] *= alpha; o1[i] *= alpha; }
                }
                float ps = 0.f;
#pragma unroll
                for (int kt = 0; kt < 4; ++kt)
#pragma unroll
                    for (int i = 0; i < 16; ++i) { const float p = fast_exp2(sc[kt][i] - mrun); sc[kt][i] = p; ps += p; }
                lrun += ps;
                __builtin_amdgcn_s_setprio(1);
#pragma unroll
                for (int kt = 0; kt < 4; ++kt)
#pragma unroll
                    for (int s = 0; s < 2; ++s) {
                        const bf16x8 pf = pack_p(sc[kt], s);
                        const LAS bf16* vb = Vl + 32 * kt;
                        const u32x2 a0 = *(const LAS u32x2*)(vb + vo[0][2 * s]), a1 = *(const LAS u32x2*)(vb + vo[0][2 * s + 1]);
                        const u32x2 b0 = *(const LAS u32x2*)(vb + vo[1][2 * s]), b1 = *(const LAS u32x2*)(vb + vo[1][2 * s + 1]);
                        u32x4 va; va.x = a0.x; va.y = a0.y; va.z = a1.x; va.w = a1.y;
                        u32x4 vb4; vb4.x = b0.x; vb4.y = b0.y; vb4.z = b1.x; vb4.w = b1.y;
                        o0 = MFMA32(__builtin_bit_cast(bf16x8, va), pf, o0); o1 = MFMA32(__builtin_bit_cast(bf16x8, vb4), pf, o1);
                    }
                __builtin_amdgcn_s_setprio(0);
            }
        }
        const float lt = lrun + __shfl_xor(lrun, 32);
        const float inv = fast_rcp(lt);
#pragma unroll
        for (int i4 = 0; i4 < 4; ++i4) {
            const u32x2 z0 = zg[i4], z1 = zg[4 + i4];
            u32x2 w0, w1;
            w0.x = cvt_pk_bf16(o0[4 * i4 + 0] * inv * bf_lo(z0.x), o0[4 * i4 + 1] * inv * bf_hi(z0.x)); w0.y = cvt_pk_bf16(o0[4 * i4 + 2] * inv * bf_lo(z0.y), o0[4 * i4 + 3] * inv * bf_hi(z0.y));
            w1.x = cvt_pk_bf16(o1[4 * i4 + 0] * inv * bf_lo(z1.x), o1[4 * i4 + 1] * inv * bf_hi(z1.x)); w1.y = cvt_pk_bf16(o1[4 * i4 + 2] * inv * bf_lo(z1.y), o1[4 * i4 + 3] * inv * bf_hi(z1.y));
            st8(GT + ob + 8 * i4, w0); st8(GT + ob + 32 + 8 * i4, w1);
        }
        }
    }
    __syncthreads();
}

constexpr int SG_WP = 136, SG_NP = 136;
__device__ __forceinline__ void sgu_phase(const Ctx& C, const bf16* U, const bf16* Vv, const bf16* Z, const float* ssum, const float* ssq, const float* lng, const float* lnb,
                                          const bf16* wsb, const float* bs_, bf16* GT) {
    LAS bf16* Wl = (LAS bf16*)C.lds;
    LAS bf16* Vn = Wl + 128 * SG_WP;
    LAS float* St = (LAS float*)(Vn + 64 * SG_NP);
    LAS float* Pp = St + 256;
    const int r = C.lane & 31, hi = C.lane >> 5;
    const int ct = C.wave & 1, tt = C.wave >> 1;
    for (int item = C.vcu; item < 256; item += C.G) {
        const int bn = item >> 1, gh = item & 1, b = bn >> 4, n = bn & 15;
        const int tok0 = b * 2048 + n * 128;
        __syncthreads();
        { const int tk = C.tid & 127, part = C.tid >> 7; float a = 0.f, q = 0.f;
#pragma unroll
          for (int s = 0; s < 8; ++s) { a += ssum[(size_t)(part * 8 + s) * MTOK + tok0 + tk]; q += ssq[(size_t)(part * 8 + s) * MTOK + tok0 + tk]; }
          Pp[(part * 128 + tk) * 2] = a; Pp[(part * 128 + tk) * 2 + 1] = q; }
        __syncthreads();
        if (C.tid < 128) {
            const float a = Pp[C.tid * 2] + Pp[(128 + C.tid) * 2] + Pp[(256 + C.tid) * 2] + Pp[(384 + C.tid) * 2];
            const float q = Pp[C.tid * 2 + 1] + Pp[(128 + C.tid) * 2 + 1] + Pp[(256 + C.tid) * 2 + 1] + Pp[(384 + C.tid) * 2 + 1];
            const float mu = a * (1.f / 1024.f), var = q * (1.f / 1024.f) - mu * mu;
            St[C.tid * 2] = mu; St[C.tid * 2 + 1] = rsqrtf(fmaxf(var, 0.f) + EPS);
        }
        const int t = 32 * tt + r;
        u32x4 wr_[4], vr_[2]; u32x2 ugn[4], zgn[4]; float bsn;
#define SGU_PREFETCH(G_) do { const int g_ = (G_); \
          _Pragma("unroll") for (int i = 0; i < 4; ++i) wr_[i] = ld16(wsb + (size_t)g_ * 16384 + (size_t)(C.tid + i * NTHREADS) * 8); \
          _Pragma("unroll") for (int i = 0; i < 2; ++i) { const int idx = C.tid + i * NTHREADS, s_ = idx >> 3, ch = idx & 7; vr_[i] = ld16(Vv + (size_t)(tok0 + s_) * 1024 + g_ * 64 + ch * 8); } \
          const size_t ob_ = (size_t)(tok0 + t) * 1024 + g_ * 64 + 32 * ct + 4 * hi; \
          _Pragma("unroll") for (int i4 = 0; i4 < 4; ++i4) { ugn[i4] = *(const u32x2*)(U + ob_ + 8 * i4); zgn[i4] = *(const u32x2*)(Z + ob_ + 8 * i4); } \
          bsn = bs_[g_ * 128 + t]; } while (0)
        SGU_PREFETCH(gh * 8);
        for (int gi = 0; gi < 8; ++gi) {
            const int g = gh * 8 + gi;
            __syncthreads();
#pragma unroll
            for (int i = 0; i < 4; ++i) { const int idx = C.tid + i * NTHREADS, tw = idx >> 4, c16 = idx & 15; *(LAS u32x4*)(Wl + tw * SG_WP + c16 * 8) = wr_[i]; }
#pragma unroll
            for (int i = 0; i < 2; ++i) {
                const int idx = C.tid + i * NTHREADS, s = idx >> 3, ch = idx & 7;
                float v[8]; unpack8(vr_[i], v);
                const float mu = St[s * 2], rs = St[s * 2 + 1];
                const f32x4 g0v = *(const f32x4*)(lng + g * 64 + ch * 8), g1v = *(const f32x4*)(lng + g * 64 + ch * 8 + 4);
                const f32x4 b0v = *(const f32x4*)(lnb + g * 64 + ch * 8), b1v = *(const f32x4*)(lnb + g * 64 + ch * 8 + 4);
                LAS bf16* vd = Vn + (ch * 8) * SG_NP + s;
#pragma unroll
                for (int j = 0; j < 8; ++j) { const float gg = j < 4 ? g0v[j] : g1v[j - 4], bb = j < 4 ? b0v[j] : b1v[j - 4]; vd[j * SG_NP] = f2bf((v[j] - mu) * rs * gg + bb); }
            }
            u32x2 ug[4], zg[4];
#pragma unroll
            for (int i4 = 0; i4 < 4; ++i4) { ug[i4] = ugn[i4]; zg[i4] = zgn[i4]; }
            const float bsv = bsn;
            __syncthreads();
            if (gi + 1 < 8) SGU_PREFETCH(g + 1);
            const size_t ob = (size_t)(tok0 + t) * 1024 + g * 64 + 32 * ct + 4 * hi;
            f32x16 acc = {0.f,0.f,0.f,0.f,0.f,0.f,0.f,0.f,0.f,0.f,0.f,0.f,0.f,0.f,0.f,0.f};
            const int nks = 2 * (tt + 1);
            for (int ks = 0; ks < nks; ++ks) {
                const bf16x8 af = *(const LAS bf16x8*)(Vn + (32 * ct + r) * SG_NP + 16 * ks + 8 * hi);
                const bf16x8 bf = *(const LAS bf16x8*)(Wl + (32 * tt + r) * SG_WP + 16 * ks + 8 * hi);
                acc = MFMA32(af, bf, acc);
            }
#pragma unroll
            for (int i4 = 0; i4 < 4; ++i4) {
                const u32x2 uu = ug[i4], zz = zg[i4];
                u32x2 w;
                w.x = cvt_pk_bf16(bf_lo(uu.x) * (acc[4 * i4 + 0] + bsv) * bf_lo(zz.x), bf_hi(uu.x) * (acc[4 * i4 + 1] + bsv) * bf_hi(zz.x));
                w.y = cvt_pk_bf16(bf_lo(uu.y) * (acc[4 * i4 + 2] + bsv) * bf_lo(zz.y), bf_hi(uu.y) * (acc[4 * i4 + 3] + bsv) * bf_hi(zz.y));
                st8(GT + ob + 8 * i4, w);
            }
        }
#undef SGU_PREFETCH
    }
    __syncthreads();
}

constexpr int NPHASE = 20;
#define AS4 __attribute__((address_space(4)))
#define PH_BEGIN const AS4 Args* ap = (const AS4 Args*)__builtin_amdgcn_kernarg_segment_ptr(); asm volatile("" : "+s"(ap)); unsigned char* const ws = ap->ws; (void)ws
#define P_XN ((bf16*)(ws + WS_XN))
#define P_ZB ((bf16*)(ws + WS_Z))
#define P_GT ((bf16*)(ws + WS_GT))
#define P_YB ((bf16*)(ws + WS_Y))
#define P_S1 ((float*)(ws + TAB_S1))
#define P_S2 ((float*)(ws + TAB_S2))
#define P_RCOS ((const float*)(ws + TAB_ROPE))
#define P_RSIN ((const float*)(ws + TAB_ROPE) + 2048 * 16)
#ifndef PH_MASK
#define PH_MASK 0xFFFFFFu
#endif
#ifndef REP_MASK
#define REP_MASK 0u
#endif
#define RUNS(k) ((((REP_MASK) >> (k)) & 1u) ? 2 : 1)
__global__ void __launch_bounds__(NTHREADS, 2) hybrid_fwd(Args args) {
    extern __shared__ __attribute__((aligned(16))) unsigned char lds_raw[];
    Ctx C;
    C.lds = (LAS unsigned char*)lds_raw;
    C.tid = threadIdx.x; C.lane = C.tid & 63; C.wave = __builtin_amdgcn_readfirstlane(C.tid >> 6);
    C.G = gridDim.x; { const int bx = blockIdx.x; C.vcu = (C.G % 8 == 0) ? (bx % 8) * (C.G / 8) + bx / 8 : bx; }
    volatile LAS unsigned* MISC = (volatile LAS unsigned*)(C.lds + LDSCTL_OFF);
    for (int u = C.tid; u < (LDS_BYTES - LDSCTL_OFF) / 4; u += NTHREADS) ((LAS unsigned*)(C.lds + LDSCTL_OFF))[u] = 0u;
    __syncthreads();
    const int lo = args.ph_lo, hi = args.ph_hi;
    if (hi - lo > 1) (void)xcd_barrier_post((unsigned*)(args.ws + WS_CTL) + CW_BAR, MISC + 8);
#define IN(k) (((PH_MASK >> (k)) & 1u) && lo <= (k) && (k) < hi)
#define SEAM(k) do { if (IN(k) && IN((k) + 1)) { XcdBarrier b_; b_.bar = (unsigned*)(((const AS4 Args*)__builtin_amdgcn_kernarg_segment_ptr())->ws + WS_CTL) + CW_BAR; b_.x = xb_xcc_id(); \
        b_.st = (volatile LAS unsigned*)(C.lds + LDSCTL_OFF) + 8; xcd_barrier(b_); } } while (0)
    LAS unsigned char* ring = C.lds;
    const int bx = (int)blockIdx.x;

    if (IN(0)) for (int rep_ = 0; rep_ < RUNS(0); ++rep_) { { PH_BEGIN; prologue(ap, C, 0, NI0 + 2 * NI1, 0); } { PH_BEGIN; prologue_tables(ap, C); } { PH_BEGIN; prologue_s5(ap, C); } } SEAM(0);

    if (IN(1)) for (int rep_ = 0; rep_ < RUNS(1); ++rep_) { PH_BEGIN; pg8::Gemm g{P_XN, (const bf16*)(ws + W_A_IN), 1024, 1024, 1024}; pg8::StaticOrder S; S.init(MTOK, 2048, C.G, bx);
        Epi8<OpAin> E{{(bf16*)(ws + S5_A2), P_ZB}}; pg8::gemm_phase<Epi8<OpAin>, pg8::StaticOrder, true>(ring, g, S, E); } SEAM(1);
    if (IN(2)) for (int rep_ = 0; rep_ < RUNS(2); ++rep_) { PH_BEGIN; pg8::Gemm g{(const bf16*)(ws + S5_A2), (const bf16*)(ws + S5_BST), 512, 640, 512}; OrderS5a S{C.vcu, C.G};
        EpiAscan E{(const float*)(ws + TAB_A32), (bf16*)(ws + S5_A2)}; pg8::gemm_phase<EpiAscan, OrderS5a, false>(ring, g, S, E);
        prologue(ap, C, NI0 + 2 * NI1, NITEMS, (C.G >= 256) ? 128 : 0); } SEAM(2);
    if (IN(3)) for (int rep_ = 0; rep_ < RUNS(3); ++rep_) { PH_BEGIN; pg8::Gemm g{(const bf16*)(ws + S5_A2), (const bf16*)(ws + S5_B2), 640, 640, 640}; OrderS5b S{C.vcu, C.G};
        Epi8<OpAy> E{{(const bf16*)(ws + S5_A2), ap->in[12], P_YB}}; pg8::gemm_phase<Epi8<OpAy>, OrderS5b, false>(ring, g, S, E); } SEAM(3);
    if (IN(4)) for (int rep_ = 0; rep_ < RUNS(4); ++rep_) { PH_BEGIN; pg8::Gemm g{P_YB, (const bf16*)(ws + W_A_GLU), 1024, 1024, 1024}; pg8::StaticOrder S; S.init(MTOK, 1024, C.G, bx);
        Epi8<OpAglu> E{{P_YB, P_ZB, ap->in[14], P_GT}}; pg8::gemm_phase<Epi8<OpAglu>, pg8::StaticOrder, false>(ring, g, S, E); } SEAM(4);
    if (IN(5)) for (int rep_ = 0; rep_ < RUNS(5); ++rep_) { PH_BEGIN; pg8::Gemm g{P_GT, (const bf16*)(ws + W_A_OUT), 1024, 1024, 1024}; pg8::StaticOrder S; S.init(MTOK, 1024, C.G, bx);
        Epi8<OpOut> E{{P_YB}}; pg8::gemm_phase<Epi8<OpOut>, pg8::StaticOrder, false>(ring, g, S, E); } SEAM(5);
    if (IN(6)) for (int rep_ = 0; rep_ < RUNS(6); ++rep_) { PH_BEGIN; row_phase(C, P_YB, ap->in[0], ap->out, ap->in[2], P_XN, true); } SEAM(6);

    if (IN(7)) for (int rep_ = 0; rep_ < RUNS(7); ++rep_) { PH_BEGIN; pg8::Gemm g{P_XN, (const bf16*)(ws + W_B_IN), 1024, 1024, 1024}; pg8::StaticOrder S; S.init(MTOK, 2304, C.G, bx);
        Epi8<OpBin> E{{(bf16*)(ws + SW_Q), (bf16*)(ws + SW_KV), P_ZB}}; pg8::gemm_phase<Epi8<OpBin>, pg8::StaticOrder, true>(ring, g, S, E); } SEAM(7);
    if (IN(8)) for (int rep_ = 0; rep_ < RUNS(8); ++rep_) { PH_BEGIN; swa_phase(C, (const bf16*)(ws + SW_Q), (const bf16*)(ws + SW_KV), P_ZB, (const float*)(ws + TAB_BIAS), ap->in[17], P_GT); } SEAM(8);
    if (IN(9)) for (int rep_ = 0; rep_ < RUNS(9); ++rep_) { PH_BEGIN; pg8::Gemm g{P_GT, (const bf16*)(ws + W_B_OUT), 1024, 1024, 1024}; pg8::StaticOrder S; S.init(MTOK, 1024, C.G, bx);
        Epi8<OpOut> E{{P_YB}}; pg8::gemm_phase<Epi8<OpOut>, pg8::StaticOrder, false>(ring, g, S, E); } SEAM(9);
    if (IN(10)) for (int rep_ = 0; rep_ < RUNS(10); ++rep_) { PH_BEGIN; row_phase(C, P_YB, ap->out, ap->out, ap->in[2] + 1024, P_XN, true); } SEAM(10);

    if (IN(11)) for (int rep_ = 0; rep_ < RUNS(11); ++rep_) { PH_BEGIN; pg8::Gemm g{P_XN, (const bf16*)(ws + W_C_IN), 1024, 1024, 1024}; pg8::StaticOrder S; S.init(MTOK, 2048, C.G, bx);
        Epi8<OpCin> E{{(bf16*)(ws + ML_CQ), (bf16*)(ws + ML_CKV), P_ZB, P_S1}}; pg8::gemm_phase<Epi8<OpCin>, pg8::StaticOrder, true>(ring, g, S, E);
        krope_phase(C, P_XN, (const bf16*)(ws + W_C_ROPE), P_RCOS, P_RSIN, (bf16*)(ws + ML_KR)); } SEAM(11);
    if (IN(12)) for (int rep_ = 0; rep_ < RUNS(12); ++rep_) { PH_BEGIN;
        { pg8::Gemm g{(const bf16*)(ws + ML_CQ), (const bf16*)(ws + W_C_UQ), 768, 768, 768}; pg8::StaticOrder S; S.init(MTOK, 1536, C.G, bx);
          Epi8<OpQ> E{{(bf16*)(ws + ML_Q)}}; pg8::gemm_phase<Epi8<OpQ>, pg8::StaticOrder, true>(ring, g, S, E); }
        { pg8::Gemm g{(const bf16*)(ws + ML_CKV), (const bf16*)(ws + W_C_UKV), 256, 256, 256};
          EpiCukv E{P_S1, (bf16*)(ws + ML_KN), (bf16*)(ws + ML_V)};
          if (C.G == 256) { OrderUkv S{bx}; pg8::gemm_phase<EpiCukv, OrderUkv, true>(ring, g, S, E); }
          else { pg8::StaticOrder S; S.init(MTOK, 2048, C.G, C.G - 1 - bx); pg8::gemm_phase<EpiCukv, pg8::StaticOrder, true>(ring, g, S, E); } }
    } SEAM(12);
    if (IN(13)) for (int rep_ = 0; rep_ < RUNS(13); ++rep_) { PH_BEGIN; mla_phase(C, (const bf16*)(ws + ML_Q), (const bf16*)(ws + ML_KN), (const bf16*)(ws + ML_KR), (const bf16*)(ws + ML_V), P_ZB, P_S1, P_RCOS, P_RSIN, P_GT); } SEAM(13);
    if (IN(14)) for (int rep_ = 0; rep_ < RUNS(14); ++rep_) { PH_BEGIN; pg8::Gemm g{P_GT, (const bf16*)(ws + W_C_OUT), 1024, 1024, 1024}; pg8::StaticOrder S; S.init(MTOK, 1024, C.G, bx);
        Epi8<OpOut> E{{P_YB}}; pg8::gemm_phase<Epi8<OpOut>, pg8::StaticOrder, false>(ring, g, S, E); } SEAM(14);
    if (IN(15)) for (int rep_ = 0; rep_ < RUNS(15); ++rep_) { PH_BEGIN; row_phase(C, P_YB, ap->out, ap->out, ap->in[2] + 2048, P_XN, true); } SEAM(15);

    if (IN(16)) for (int rep_ = 0; rep_ < RUNS(16); ++rep_) { PH_BEGIN; pg8::Gemm g{P_XN, (const bf16*)(ws + W_D_IN), 1024, 1024, 1024}; pg8::StaticOrder S; S.init(MTOK, 3072, C.G, bx);
        Epi8<OpDin> E{{(bf16*)(ws + SG_U), (bf16*)(ws + SG_V), P_ZB, P_S1, P_S2}}; pg8::gemm_phase<Epi8<OpDin>, pg8::StaticOrder, true>(ring, g, S, E); } SEAM(16);
    if (IN(17)) for (int rep_ = 0; rep_ < RUNS(17); ++rep_) { PH_BEGIN; sgu_phase(C, (const bf16*)(ws + SG_U), (const bf16*)(ws + SG_V), P_ZB, P_S1, P_S2, ap->in[26], ap->in[27], (const bf16*)(ws + TAB_WS), ap->in[29], P_GT); } SEAM(17);
    if (IN(18)) for (int rep_ = 0; rep_ < RUNS(18); ++rep_) { PH_BEGIN; pg8::Gemm g{P_GT, (const bf16*)(ws + W_D_OUT), 1024, 1024, 1024}; pg8::StaticOrder S; S.init(MTOK, 1024, C.G, bx);
        Epi8<OpOut> E{{P_YB}}; pg8::gemm_phase<Epi8<OpOut>, pg8::StaticOrder, false>(ring, g, S, E); } SEAM(18);
    if (IN(19)) for (int rep_ = 0; rep_ < RUNS(19); ++rep_) { PH_BEGIN; row_phase(C, P_YB, ap->out, ap->out, ap->in[2] + 3072, P_XN, false); }
#undef IN
#undef SEAM
}

extern "C" void kernel_launch(void* const* d_in, const int* in_sizes, int n_in, void* d_out, int out_size, void* d_ws, size_t ws_size, hipStream_t stream) {
    static int grid = 0;
    if (grid == 0) {
        if (n_in != 31 || out_size != MTOK * DM || ws_size < WS_END) { fprintf(stderr, "kernel_launch: unexpected shapes (n_in %d, out %d, ws %zu)\n", n_in, out_size, ws_size); grid = -1; return; }
        int dev = 0, cus = 0, per_cu = 0;
        if (hipGetDevice(&dev) != hipSuccess || hipDeviceGetAttribute(&cus, hipDeviceAttributeMultiprocessorCount, dev) != hipSuccess) { grid = -1; return; }
        if (hipFuncSetAttribute((const void*)hybrid_fwd, hipFuncAttributeMaxDynamicSharedMemorySize, LDS_BYTES) != hipSuccess) { fprintf(stderr, "kernel_launch: hipFuncSetAttribute failed\n"); grid = -1; return; }
        if (hipOccupancyMaxActiveBlocksPerMultiprocessor(&per_cu, (const void*)hybrid_fwd, NTHREADS, LDS_BYTES) != hipSuccess || per_cu < 1)
            fprintf(stderr, "kernel_launch: occupancy query reports %d workgroups per CU\n", per_cu);
        (void)hipGetLastError();
        grid = cus;
    }
    if (grid < 0) return;
    (void)hipMemsetAsync((char*)d_ws + WS_CTL, 0, CTL_ZERO_BYTES, stream);
    Args a{};
    for (int i = 0; i < 31; ++i) a.in[i] = (const float*)d_in[i];
    a.out = (float*)d_out; a.ws = (unsigned char*)d_ws;
#if MK_ONE_LAUNCH
    a.ph_lo = 0; a.ph_hi = NPHASE;
    hipLaunchKernelGGL(hybrid_fwd, dim3(grid), dim3(NTHREADS), LDS_BYTES, stream, a);
#else
    for (int p = 0; p < NPHASE; ++p) { a.ph_lo = p; a.ph_hi = p + 1; hipLaunchKernelGGL(hybrid_fwd, dim3(grid), dim3(NTHREADS), LDS_BYTES, stream, a); }
#endif
}
```
